# Optimizing an MI355X kernel written in HIP

```python
import math
import jax
import jax.numpy as jnp
from jax import lax
import numpy as np

D_MODEL = 1024
BATCH = 2
SEQ = 8192
DEPTH = 4

GRID_W = 64
CTX_LEN = 256
N_MIXERS = 4
HEAD_DIM = 64
GQA_HEADS = 16
GQA_KV_HEADS = 4
CONV_WIDTH = 31
DIFF_HEADS = 8
DIFF_V_DIM = 2 * HEAD_DIM
SWA_HEADS = 16
SWA_KV_HEADS = 4
WINDOW = 128
Q_BLOCK = 128
D_FF = 4 * D_MODEL
ROPE_THETA = 10000.0
EPS = 1e-6
NEG_INF = -1e30

kernel_name = 'hybrid_interleaved_dit_prefix_trunk'


def _n_layers_of(m):
    return (DEPTH - m + N_MIXERS - 1) // N_MIXERS


def rms_norm(x, g):
    xf = x.astype(jnp.float32)
    y = xf * lax.rsqrt(jnp.mean(xf * xf, axis=-1, keepdims=True) + EPS)
    return (y * g.astype(jnp.float32)).astype(x.dtype)


def layer_norm(x, g, b):
    xf = x.astype(jnp.float32)
    mu = jnp.mean(xf, axis=-1, keepdims=True)
    var = jnp.mean(jnp.square(xf - mu), axis=-1, keepdims=True)
    y = (xf - mu) * lax.rsqrt(var + EPS)
    return (y * g.astype(jnp.float32) + b.astype(jnp.float32)).astype(x.dtype)


def modulate(x, g, shift, scale):
    return rms_norm(x, g) * (1 + scale) + shift


def rope_2d(rows, dim):
    row = jnp.repeat(jnp.arange(rows, dtype=jnp.float32), GRID_W)
    col = jnp.tile(jnp.arange(GRID_W, dtype=jnp.float32), rows)
    half = dim // 2
    inv = 1.0 / jnp.power(ROPE_THETA, jnp.arange(0, half, 2, dtype=jnp.float32) / half)
    ang = jnp.concatenate([row[:, None] * inv, col[:, None] * inv], axis=-1)
    return jnp.cos(ang), jnp.sin(ang)


def apply_rope(x, cos, sin):
    shp = x.shape
    extra = x.ndim - 3
    tab = (1, cos.shape[0]) + (1,) * extra + (cos.shape[1],)
    c, s = cos.reshape(tab), sin.reshape(tab)
    xf = x.astype(jnp.float32).reshape(shp[:-1] + (shp[-1] // 2, 2))
    x1, x2 = xf[..., 0], xf[..., 1]
    out = jnp.stack([x1 * c - x2 * s, x1 * s + x2 * c], axis=-1).reshape(shp)
    return out.astype(x.dtype)


def _to_blocks(x):
    b, t = x.shape[:2]
    return jnp.moveaxis(x.reshape((b, t // Q_BLOCK, Q_BLOCK) + x.shape[2:]), 1, 0)


def _from_blocks(x):
    x = jnp.moveaxis(x, 0, 1)
    return x.reshape((x.shape[0], x.shape[1] * x.shape[2]) + x.shape[3:])


def gqa_project(h, w_qkv, q_g, k_g, n_heads, n_kv):
    b, t = h.shape[:2]
    q, k, v = jnp.split(h @ w_qkv, [n_heads * HEAD_DIM, (n_heads + n_kv) * HEAD_DIM], axis=-1)
    q = rms_norm(q.reshape(b, t, n_kv, n_heads // n_kv, HEAD_DIM), q_g)
    k = rms_norm(k.reshape(b, t, n_kv, HEAD_DIM), k_g)
    return q, k, v.reshape(b, t, n_kv, HEAD_DIM)


def gqa_scores(q, k):
    return jnp.einsum('bqhgd,bkhd->bhgqk', q, k, preferred_element_type=jnp.float32) / math.sqrt(q.shape[-1])


def gqa_attend(q, k, v):
    p = jax.nn.softmax(gqa_scores(q, k), axis=-1)
    return jnp.einsum('bhgqk,bkhd->bqhgd', p.astype(v.dtype), v)


def mixer_dense_gqa(h, hc, w_qkv, q_g, k_g, w_o, cos, sin, need_ctx):
    b, t = h.shape[:2]
    q, k, v = gqa_project(h, w_qkv, q_g, k_g, GQA_HEADS, GQA_KV_HEADS)
    q, k = apply_rope(q, cos, sin), apply_rope(k, cos, sin)
    qc, kc, vc = gqa_project(hc, w_qkv, q_g, k_g, GQA_HEADS, GQA_KV_HEADS)
    k_all = jnp.concatenate([kc, k], axis=1)
    v_all = jnp.concatenate([vc, v], axis=1)
    o = _from_blocks(lax.map(lambda qb: gqa_attend(qb, k_all, v_all), _to_blocks(q)))
    y = o.reshape(b, t, -1) @ w_o
    yc = gqa_attend(qc, kc, vc).reshape(b, hc.shape[1], -1) @ w_o if need_ctx else None
    return y, yc


def conformer_conv(h, w_pw1, b_pw1, w_dw, b_dw, ln_g, ln_b, w_pw2, b_pw2):
    a, g = jnp.split(h @ w_pw1 + b_pw1, 2, axis=-1)
    u = a * jax.nn.sigmoid(g)
    u = lax.conv_general_dilated(u, w_dw[:, None, :].astype(u.dtype), window_strides=(1,),
                                 padding=[(CONV_WIDTH // 2, CONV_WIDTH // 2)],
                                 dimension_numbers=('NWC', 'WIO', 'NWC'),
                                 feature_group_count=u.shape[-1]) + b_dw
    u = jax.nn.silu(layer_norm(u, ln_g, ln_b))
    return u @ w_pw2 + b_pw2


def mixer_conformer(h, hc, w_pw1, b_pw1, w_dw, b_dw, ln_g, ln_b, w_pw2, b_pw2, need_ctx):
    y = conformer_conv(h, w_pw1, b_pw1, w_dw, b_dw, ln_g, ln_b, w_pw2, b_pw2)
    yc = conformer_conv(hc, w_pw1, b_pw1, w_dw, b_dw, ln_g, ln_b, w_pw2, b_pw2) if need_ctx else None
    return y, yc


def diff_project(h, w_qkv, q_g, k_g):
    b, t = h.shape[:2]
    q, k, v = jnp.split(h @ w_qkv, 3, axis=-1)
    q = rms_norm(q.reshape(b, t, DIFF_HEADS, 2, HEAD_DIM), q_g)
    k = rms_norm(k.reshape(b, t, DIFF_HEADS, 2, HEAD_DIM), k_g)
    return q, k, v.reshape(b, t, DIFF_HEADS, DIFF_V_DIM)


def diff_attend(q, k, v, lam):
    s = jnp.einsum('bqhcd,bkhcd->bchqk', q, k, preferred_element_type=jnp.float32) / math.sqrt(HEAD_DIM)
    p = jax.nn.softmax(s, axis=-1)
    a = p[:, 0] - lam * p[:, 1]
    return jnp.einsum('bhqk,bkhd->bqhd', a.astype(v.dtype), v)


def mixer_diff(h, hc, w_qkv, q_g, k_g, lq1, lk1, lq2, lk2, subln_g, w_o, lam_init, cos, sin, need_ctx):
    b, t = h.shape[:2]
    f32 = jnp.float32
    lam = (jnp.exp(jnp.sum(lq1.astype(f32) * lk1.astype(f32)))
           - jnp.exp(jnp.sum(lq2.astype(f32) * lk2.astype(f32))) + lam_init)
    q, k, v = diff_project(h, w_qkv, q_g, k_g)
    q, k = apply_rope(q, cos, sin), apply_rope(k, cos, sin)
    qc, kc, vc = diff_project(hc, w_qkv, q_g, k_g)
    k_all = jnp.concatenate([kc, k], axis=1)
    v_all = jnp.concatenate([vc, v], axis=1)

    def out(o):
        return (rms_norm(o, subln_g) * (1.0 - lam_init)).reshape(o.shape[0], o.shape[1], -1) @ w_o

    o = _from_blocks(lax.map(lambda qb: diff_attend(qb, k_all, v_all, lam), _to_blocks(q)))
    y = out(o)
    yc = out(diff_attend(qc, kc, vc, lam)) if need_ctx else None
    return y, yc


def mixer_window_gqa(h, hc, w_qkv, q_g, k_g, sink, w_o, cos, sin, need_ctx):
    b, t = h.shape[:2]
    q, k, v = gqa_project(h, w_qkv, q_g, k_g, SWA_HEADS, SWA_KV_HEADS)
    q, k = apply_rope(q, cos, sin), apply_rope(k, cos, sin)
    qc, kc, vc = gqa_project(hc, w_qkv, q_g, k_g, SWA_HEADS, SWA_KV_HEADS)
    sink_logit = sink.astype(jnp.float32).reshape(1, SWA_KV_HEADS, SWA_HEADS // SWA_KV_HEADS, 1, 1)
    span = Q_BLOCK + 2 * WINDOW
    pad = ((0, 0), (WINDOW, WINDOW), (0, 0), (0, 0))
    k_pad, v_pad = jnp.pad(k, pad), jnp.pad(v, pad)
    rel = jnp.arange(span)[None, :] - WINDOW - jnp.arange(Q_BLOCK)[:, None]
    in_band = jnp.abs(rel) <= WINDOW
    n_ctx = kc.shape[1]

    def with_sink(s):
        col = jnp.broadcast_to(sink_logit, s.shape[:-1] + (1,))
        return jax.nn.softmax(jnp.concatenate([s, col], axis=-1), axis=-1)[..., :-1]

    def block(args):
        i, qb = args
        start = i * Q_BLOCK
        kb = lax.dynamic_slice_in_dim(k_pad, start, span, axis=1)
        vb = lax.dynamic_slice_in_dim(v_pad, start, span, axis=1)
        kpos = start - WINDOW + jnp.arange(span)
        valid = in_band & ((kpos >= 0) & (kpos < t))[None, :]
        s = jnp.concatenate([jnp.where(valid, gqa_scores(qb, kb), NEG_INF), gqa_scores(qb, kc)], axis=-1)
        p = with_sink(s).astype(v.dtype)
        return (jnp.einsum('bhgqk,bkhd->bqhgd', p[..., :span], vb)
                + jnp.einsum('bhgqk,bkhd->bqhgd', p[..., span:span + n_ctx], vc))

    o = _from_blocks(lax.map(block, (jnp.arange(t // Q_BLOCK), _to_blocks(q))))
    y = o.reshape(b, t, -1) @ w_o
    yc = None
    if need_ctx:
        pc = with_sink(gqa_scores(qc, kc)).astype(vc.dtype)
        yc = jnp.einsum('bhgqk,bkhd->bqhgd', pc, vc).reshape(b, n_ctx, -1) @ w_o
    return y, yc


def squared_relu_mlp(h, w_up, w_down):
    return jnp.square(jax.nn.relu(h @ w_up)) @ w_down


def setup_inputs(seed: int = 0) -> dict:
    key = jax.random.key(seed)
    ks = iter(jax.random.split(key, 48))
    D = D_MODEL

    def nrm(shape, scale):
        return jax.random.normal(next(ks), shape, jnp.float32) * scale

    def gain(shape):
        return 1.0 + nrm(shape, 0.02)

    nA, nB, nC, nD = (_n_layers_of(m) for m in range(N_MIXERS))
    gqa_w = (GQA_HEADS + 2 * GQA_KV_HEADS) * HEAD_DIM
    swa_w = (SWA_HEADS + 2 * SWA_KV_HEADS) * HEAD_DIM
    return {
        'x': nrm((BATCH, SEQ, D), 1.0),
        'c': nrm((BATCH, D), 1.0),
        'ctx': nrm((BATCH, CTX_LEN, D), 1.0),
        'c_ctx': nrm((D,), 1.0),
        'norm1_g': gain((DEPTH, D)),
        'norm2_g': gain((DEPTH, D)),
        'mod_w': nrm((DEPTH, D, 6 * D), 0.5 * D ** -0.5),
        'mod_b': nrm((DEPTH, 6 * D), 0.02),
        'mlp_up': nrm((DEPTH, D, D_FF), D ** -0.5),
        'mlp_down': nrm((DEPTH, D_FF, D), D_FF ** -0.5),
        'gqa_w_qkv': nrm((nA, D, gqa_w), D ** -0.5),
        'gqa_q_g': gain((nA, HEAD_DIM)),
        'gqa_k_g': gain((nA, HEAD_DIM)),
        'gqa_w_o': nrm((nA, GQA_HEADS * HEAD_DIM, D), (GQA_HEADS * HEAD_DIM) ** -0.5),
        'conv_w_pw1': nrm((nB, D, 2 * D), D ** -0.5),
        'conv_b_pw1': nrm((nB, 2 * D), 0.02),
        'conv_w_dw': nrm((nB, CONV_WIDTH, D), CONV_WIDTH ** -0.5),
        'conv_b_dw': nrm((nB, D), 0.02),
        'conv_ln_g': gain((nB, D)),
        'conv_ln_b': nrm((nB, D), 0.02),
        'conv_w_pw2': nrm((nB, D, D), D ** -0.5),
        'conv_b_pw2': nrm((nB, D), 0.02),
        'diff_w_qkv': nrm((nC, D, 3 * DIFF_HEADS * DIFF_V_DIM), D ** -0.5),
        'diff_q_g': gain((nC, HEAD_DIM)),
        'diff_k_g': gain((nC, HEAD_DIM)),
        'diff_lam_q1': nrm((nC, HEAD_DIM), 0.1),
        'diff_lam_k1': nrm((nC, HEAD_DIM), 0.1),
        'diff_lam_q2': nrm((nC, HEAD_DIM), 0.1),
        'diff_lam_k2': nrm((nC, HEAD_DIM), 0.1),
        'diff_subln_g': gain((nC, DIFF_V_DIM)),
        'diff_w_o': nrm((nC, DIFF_HEADS * DIFF_V_DIM, D), (DIFF_HEADS * DIFF_V_DIM) ** -0.5),
        'swa_w_qkv': nrm((nD, D, swa_w), D ** -0.5),
        'swa_q_g': gain((nD, HEAD_DIM)),
        'swa_k_g': gain((nD, HEAD_DIM)),
        'swa_sink': nrm((nD, SWA_HEADS), 0.5),
        'swa_w_o': nrm((nD, SWA_HEADS * HEAD_DIM, D), (SWA_HEADS * HEAD_DIM) ** -0.5),
    }


def reference(x, c, ctx, c_ctx, norm1_g, norm2_g, mod_w, mod_b, mlp_up, mlp_down,
              gqa_w_qkv, gqa_q_g, gqa_k_g, gqa_w_o,
              conv_w_pw1, conv_b_pw1, conv_w_dw, conv_b_dw, conv_ln_g, conv_ln_b, conv_w_pw2, conv_b_pw2,
              diff_w_qkv, diff_q_g, diff_k_g, diff_lam_q1, diff_lam_k1, diff_lam_q2, diff_lam_k2,
              diff_subln_g, diff_w_o,
              swa_w_qkv, swa_q_g, swa_k_g, swa_sink, swa_w_o):
    rows = x.shape[1] // GRID_W
    cos, sin = rope_2d(rows, HEAD_DIM)
    s_lat = jax.nn.silu(c)
    s_ctx = jax.nn.silu(c_ctx)
    xc = ctx
    for i in range(DEPTH):
        m, j = i % N_MIXERS, i // N_MIXERS
        need_ctx = i < DEPTH - 1
        mod_l = (s_lat @ mod_w[i] + mod_b[i])[:, None, :]
        mod_c = (s_ctx @ mod_w[i] + mod_b[i])[None, None, :]
        sh1, sc1, g1, sh2, sc2, g2 = jnp.split(mod_l, 6, axis=-1)
        csh1, csc1, cg1, csh2, csc2, cg2 = jnp.split(mod_c, 6, axis=-1)
        h = modulate(x, norm1_g[i], sh1, sc1)
        hc = modulate(xc, norm1_g[i], csh1, csc1)
        if m == 0:
            y, yc = mixer_dense_gqa(h, hc, gqa_w_qkv[j], gqa_q_g[j], gqa_k_g[j], gqa_w_o[j], cos, sin, need_ctx)
        elif m == 1:
            y, yc = mixer_conformer(h, hc, conv_w_pw1[j], conv_b_pw1[j], conv_w_dw[j], conv_b_dw[j],
                                    conv_ln_g[j], conv_ln_b[j], conv_w_pw2[j], conv_b_pw2[j], need_ctx)
        elif m == 2:
            lam_init = 0.8 - 0.6 * math.exp(-0.3 * i)
            y, yc = mixer_diff(h, hc, diff_w_qkv[j], diff_q_g[j], diff_k_g[j], diff_lam_q1[j], diff_lam_k1[j],
                               diff_lam_q2[j], diff_lam_k2[j], diff_subln_g[j], diff_w_o[j], lam_init,
                               cos, sin, need_ctx)
        else:
            y, yc = mixer_window_gqa(h, hc, swa_w_qkv[j], swa_q_g[j], swa_k_g[j], swa_sink[j], swa_w_o[j],
                                     cos, sin, need_ctx)
        x = x + g1 * y
        x = x + g2 * squared_relu_mlp(modulate(x, norm2_g[i], sh2, sc2), mlp_up[i], mlp_down[i])
        if need_ctx:
            xc = xc + cg1 * yc
            xc = xc + cg2 * squared_relu_mlp(modulate(xc, norm2_g[i], csh2, csc2), mlp_up[i], mlp_down[i])
    return x
```

```cpp
#include <hip/hip_runtime.h>
#include <hip/hip_cooperative_groups.h>
#include <cstdio>
#include <cstdint>
namespace cg = cooperative_groups;
namespace pg8 {
#define PG8_LAS __attribute__((address_space(3)))
typedef unsigned short bf16_t;
typedef short bf16x8 __attribute__((ext_vector_type(8)));
typedef float f32x4 __attribute__((ext_vector_type(4)));
typedef unsigned u32x4 __attribute__((ext_vector_type(4)));
constexpr int BM = 256, BK = 64, HALF = 128, HTB = HALF * BK * 2  , STAGE_BYTES = 8 * HTB, NXCD = 8, WGM = 8;

__host__ __device__ __forceinline__ int lds_byte(int r, int c) { const int st = (r >> 4) * 2 + (c >> 5), rr = r & 15, cc = c & 31, ob = rr * 64 + cc * 2; return st * 1024 + (ob ^ (((ob >> 9) & 1) << 5)); }
__host__ __device__ __forceinline__ void stage_rc(int b, int& R, int& C) { const int st = b / 1024, sb = b % 1024, swz = sb ^ (((sb >> 9) & 1) << 5); R = (st >> 1) * 16 + swz / 64; C = (st & 1) * 32 + (swz % 64) / 2; }
__host__ __device__ __forceinline__ int perm32(int rho) { const int n = rho >> 4, i = rho & 15; return 8 * (i >> 2) + 4 * n + (i & 3); }

struct Unit { int pm, pn; };
struct Gemm { const bf16_t* A; const bf16_t* Bt; int M, N, K; };

struct StaticOrder {
    int nM, nN, nwg, G, c;
    __host__ __device__ void init(int M, int N, int G_, int c_) { nM = M / BM; nN = N / BM; nwg = nM * nN; G = G_; c = c_; }
    __host__ __device__ bool next(int i, Unit& u) const {
        const long L = (long)i * G + c; if (L >= nwg) return false;
        int wgid = (int)L; { const int q = nwg / NXCD, r = nwg % NXCD, xcd = wgid % NXCD, off = wgid / NXCD; wgid = (xcd < r ? xcd * (q + 1) : r * (q + 1) + (xcd - r) * q) + off; }
        const int nig = WGM * nN, gid = wgid / nig, fm = gid * WGM, gsz = (nM - fm) < WGM ? (nM - fm) : WGM;
        u.pm = fm + ((wgid % nig) % gsz); u.pn = (wgid % nig) / gsz; return true;
    }
    __device__ __forceinline__ void a_ready(const Unit&) const {}
    __device__ __forceinline__ void done(const Unit&) const {}
};

__device__ __forceinline__ unsigned cvt_pk_bf16(float lo, float hi) { unsigned r; asm volatile("v_cvt_pk_bf16_f32 %0, %1, %2" : "=v"(r) : "v"(lo), "v"(hi)); return r; }
typedef float f32x2 __attribute__((ext_vector_type(2)));
__device__ __forceinline__ f32x2 gelu_pk(f32x2 v) {
    const f32x2 av = __builtin_elementwise_abs(v), d = av * 0.2316418882f + 1.0f;
    f32x2 t; t.x = __builtin_amdgcn_rcpf(d.x); t.y = __builtin_amdgcn_rcpf(d.y);
    f32x2 q = t * 0.5307027145f + (-0.7265760135f); q = q * t + 0.7107068705f; q = q * t + (-0.142248368f); q = q * t + 0.127414796f; q = q * t;
    const f32x2 s = (v * v) * (-0.72134752044f);
    f32x2 e; e.x = __builtin_amdgcn_exp2f(s.x); e.y = __builtin_amdgcn_exp2f(s.y);
    const f32x2 m = v * (q * e), r = v - m;
    f32x2 o; o.x = v.x < 0.f ? m.x : r.x; o.y = v.y < 0.f ? m.y : r.y; return o;
}

template <int ACT  > struct EpiBf16 {
    static constexpr bool PERM = true, AFTER_DRAIN = false; static_assert(ACT == 0 || ACT == 1, "EpiBf16: ACT is 0 (none) or 1 (gelu_pk)");
    bf16_t* O; int ldc; const float* bias; int split_cols; size_t split_stride; float scale0;
    __device__ __forceinline__ void operator()(const f32x4 (&acc)[2][2][4][2], const Unit& u, int wr, int wc, int fr, int fq) const {
        const int row0 = u.pm * BM + wr * 64 + fr; int colt = u.pn * BM; bf16_t* base = O;
        float sc = 1.f; if (split_cols) { const int t = colt / split_cols; base += (size_t)t * split_stride; colt -= t * split_cols; if (t == 0) sc = scale0; }
        const int col0 = colt + wc * 32 + 8 * fq, bcol0 = u.pn * BM + wc * 32 + 8 * fq;
        f32x4 bv[2][2];
#pragma unroll
        for (int bj = 0; bj < 2; ++bj)
#pragma unroll
            for (int n = 0; n < 2; ++n) bv[bj][n] = bias ? *(const f32x4*)(bias + bcol0 + bj * HALF + 4 * n) : (f32x4){0.f, 0.f, 0.f, 0.f};
#pragma unroll
        for (int ai = 0; ai < 2; ++ai)
#pragma unroll
            for (int m = 0; m < 4; ++m) { bf16_t* rowp = base + (size_t)(row0 + ai * HALF + m * 16) * ldc + col0;
#pragma unroll
                for (int bj = 0; bj < 2; ++bj) { f32x4 v0 = acc[ai][bj][m][0] + bv[bj][0], v1 = acc[ai][bj][m][1] + bv[bj][1];
                    if (ACT == 1) { f32x2 a = gelu_pk((f32x2){v0[0], v0[1]}), b = gelu_pk((f32x2){v0[2], v0[3]}), c = gelu_pk((f32x2){v1[0], v1[1]}), d = gelu_pk((f32x2){v1[2], v1[3]});
                        v0 = (f32x4){a.x, a.y, b.x, b.y}; v1 = (f32x4){c.x, c.y, d.x, d.y}; }
                    v0 = v0 * sc; v1 = v1 * sc; u32x4 w; w.x = cvt_pk_bf16(v0[0], v0[1]); w.y = cvt_pk_bf16(v0[2], v0[3]); w.z = cvt_pk_bf16(v1[0], v1[1]); w.w = cvt_pk_bf16(v1[2], v1[3]);
                    *(u32x4*)(rowp + bj * HALF) = w; } }
    }
};

template <int ACT> struct EpiSt {
    static constexpr bool PERM = true, AFTER_DRAIN = false;
    bf16_t* O; int ldc;
    __device__ __forceinline__ void operator()(const f32x4 (&acc)[2][2][4][2], const Unit& u, int wr, int wc, int fr, int fq) const {
        const int row0 = u.pm * BM + wr * 64 + fr, col0 = u.pn * BM + wc * 32 + 8 * fq;
#pragma unroll
        for (int ai = 0; ai < 2; ++ai)
#pragma unroll
            for (int m = 0; m < 4; ++m) { bf16_t* rowp = O + (size_t)(row0 + ai * HALF + m * 16) * ldc + col0;
#pragma unroll
                for (int bj = 0; bj < 2; ++bj) { f32x4 v0 = acc[ai][bj][m][0], v1 = acc[ai][bj][m][1];
                    if (ACT == 2) {
#pragma unroll
                        for (int e = 0; e < 4; ++e) { const float a = v0[e] > 0.f ? v0[e] : 0.f, b = v1[e] > 0.f ? v1[e] : 0.f; v0[e] = a * a; v1[e] = b * b; } }
                    u32x4 w; w.x = cvt_pk_bf16(v0[0], v0[1]); w.y = cvt_pk_bf16(v0[2], v0[3]); w.z = cvt_pk_bf16(v1[0], v1[1]); w.w = cvt_pk_bf16(v1[2], v1[3]);
                    *(u32x4*)(rowp + bj * HALF) = w; } }
    }
};
struct EpiGlu {
    static constexpr bool PERM = true, AFTER_DRAIN = false;
    bf16_t* O; const float* bias;
    __device__ __forceinline__ void operator()(const f32x4 (&acc)[2][2][4][2], const Unit& u, int wr, int wc, int fr, int fq) const {
        const int row0 = u.pm * BM + wr * 64 + fr, ch0 = u.pn * HALF + wc * 32 + 8 * fq;
        f32x4 ba[2], bg[2];
#pragma unroll
        for (int n = 0; n < 2; ++n) { ba[n] = *(const f32x4*)(bias + ch0 + 4 * n); bg[n] = *(const f32x4*)(bias + 1024 + ch0 + 4 * n); }
#pragma unroll
        for (int ai = 0; ai < 2; ++ai)
#pragma unroll
            for (int m = 0; m < 4; ++m) { bf16_t* rowp = O + (size_t)(row0 + ai * HALF + m * 16) * 1024 + ch0;
                f32x4 r[2];
#pragma unroll
                for (int n = 0; n < 2; ++n) { const f32x4 a = acc[ai][0][m][n] + ba[n], g = acc[ai][1][m][n] + bg[n];
#pragma unroll
                    for (int e = 0; e < 4; ++e) r[n][e] = a[e] / (1.0f + __expf(-g[e])); }
                u32x4 w; w.x = cvt_pk_bf16(r[0][0], r[0][1]); w.y = cvt_pk_bf16(r[0][2], r[0][3]); w.z = cvt_pk_bf16(r[1][0], r[1][1]); w.w = cvt_pk_bf16(r[1][2], r[1][3]);
                *(u32x4*)(rowp) = w; }
    }
};
struct EpiRes {
    static constexpr bool PERM = false, AFTER_DRAIN = false;
    const float* Xin; float* Xout; const float* gate; const float* bias;
    __device__ __forceinline__ void operator()(const f32x4 (&acc)[2][2][4][2], const Unit& u, int wr, int wc, int fr, int fq) const {
        const int r0 = u.pm * BM; const int rt = r0 < 8192 ? 0 : (r0 < 16384 ? 1 : 2);
        const float* gp = gate + rt * 6144;
        const int col0 = u.pn * BM + wc * 32 + 4 * fq;
        f32x4 gv[2][2], bv[2][2];
#pragma unroll
        for (int bj = 0; bj < 2; ++bj)
#pragma unroll
            for (int n = 0; n < 2; ++n) { const int c = col0 + bj * HALF + n * 16; gv[bj][n] = *(const f32x4*)(gp + c); bv[bj][n] = bias ? *(const f32x4*)(bias + c) : (f32x4){0.f, 0.f, 0.f, 0.f}; }
#pragma unroll
        for (int ai = 0; ai < 2; ++ai)
#pragma unroll
            for (int m = 0; m < 4; ++m) { const size_t off = (size_t)(r0 + ai * HALF + wr * 64 + m * 16 + fr) * 1024 + col0;
#pragma unroll
                for (int bj = 0; bj < 2; ++bj)
#pragma unroll
                    for (int n = 0; n < 2; ++n) { const size_t p = off + bj * HALF + n * 16; f32x4 x = *(const f32x4*)(Xin + p); x = x + gv[bj][n] * (acc[ai][bj][m][n] + bv[bj][n]); *(f32x4*)(Xout + p) = x; }
                if (m & 1) asm volatile("" ::: "memory"); }
    }
};

struct EpiQKV {
    static constexpr bool PERM = false, AFTER_DRAIN = false;
    bf16_t* O; int pitch; int nk; const float* gq; const float* gk; const float* rope; bf16_t* Vt; int vpitch; float qscale; float eps;
    __device__ __forceinline__ void operator()(const f32x4 (&acc)[2][2][4][2], const Unit& u, int wr, int wc, int fr, int fq) const {
        const int r0 = u.pm * BM + wr * 64 + fr; const bool lat = u.pm * BM < 16384;
        if (u.pn < 4 + nk) {
            const bool isq = u.pn < 4; const float* g = isq ? gq : gk; const float sc = isq ? qscale : 1.0f;
            f32x4 g4[2][2];
#pragma unroll
            for (int bj = 0; bj < 2; ++bj)
#pragma unroll
                for (int n = 0; n < 2; ++n) g4[bj][n] = *(const f32x4*)(g + 32 * bj + 16 * n + 4 * fq);
#pragma unroll
            for (int ai = 0; ai < 2; ++ai)
#pragma unroll
                for (int m = 0; m < 4; ++m) { const int row = r0 + ai * HALF + m * 16; const int t = row & 8191;
                    float ss = 0.f;
#pragma unroll
                    for (int bj = 0; bj < 2; ++bj)
#pragma unroll
                        for (int n = 0; n < 2; ++n) { const f32x4 v = acc[ai][bj][m][n]; ss += (v[0] * v[0] + v[1] * v[1]) + (v[2] * v[2] + v[3] * v[3]); }
                    ss += __shfl_xor(ss, 16); ss += __shfl_xor(ss, 32);
                    const float rs = sc / sqrtf(ss * (1.0f / 64.0f) + eps);
                    bf16_t* op = O + (size_t)row * pitch + u.pn * BM + wc * 64 + 4 * fq;
#pragma unroll
                    for (int bj = 0; bj < 2; ++bj)
#pragma unroll
                        for (int n = 0; n < 2; ++n) { const f32x4 cs = lat ? *(const f32x4*)(rope + (size_t)t * 64 + 32 * bj + 16 * n + 4 * fq) : (f32x4){1.f, 0.f, 1.f, 0.f};
                            const f32x4 y = acc[ai][bj][m][n] * g4[bj][n] * rs;
                            const float o0 = y[0] * cs[0] - y[1] * cs[1], o1 = y[0] * cs[1] + y[1] * cs[0], o2 = y[2] * cs[2] - y[3] * cs[3], o3 = y[2] * cs[3] + y[3] * cs[2];
                            unsigned w0 = cvt_pk_bf16(o0, o1), w1 = cvt_pk_bf16(o2, o3);
                            typedef unsigned u32x2_ __attribute__((ext_vector_type(2)));
                            *(u32x2_*)(op + 32 * bj + 16 * n) = (u32x2_){w0, w1}; }
                    if (m & 1) asm volatile("" ::: "memory"); }
        } else {
            const int vc0 = (u.pn - 4 - nk) * BM + wc * 64 + 4 * fq;
#pragma unroll
            for (int ai = 0; ai < 2; ++ai)
#pragma unroll
                for (int m = 0; m < 4; ++m) { const int row = r0 + ai * HALF + m * 16;
#pragma unroll
                    for (int bj = 0; bj < 2; ++bj)
#pragma unroll
                        for (int n = 0; n < 2; ++n) { const f32x4 v = acc[ai][bj][m][n]; const unsigned w0 = cvt_pk_bf16(v[0], v[1]), w1 = cvt_pk_bf16(v[2], v[3]);
                            bf16_t* vp = Vt + (size_t)(vc0 + 32 * bj + 16 * n) * vpitch + row;
                            vp[0] = (bf16_t)(w0 & 0xffffu); vp[vpitch] = (bf16_t)(w0 >> 16); vp[2 * (size_t)vpitch] = (bf16_t)(w1 & 0xffffu); vp[3 * (size_t)vpitch] = (bf16_t)(w1 >> 16); } }
        }
    }
};

template <class Epi, class Sched, bool ALIGN_EPI = false, bool SP2 = false>
__device__ __forceinline__ void gemm_phase(PG8_LAS unsigned char* lds, const Gemm g, const Sched& S, const Epi& E) {
    int tid_o = threadIdx.x; asm volatile("" : "+v"(tid_o)); const int tid = tid_o, wid = __builtin_amdgcn_readfirstlane(tid >> 6), lane = tid & 63, wr = wid >> 2, wc = wid & 3, fr = lane & 15, fq = lane >> 4;
    const int K = g.K, nt = K / BK;
    unsigned voffA[2], voffB[2];
#pragma unroll
    for (int i = 0; i < 2; ++i) { int R, C; stage_rc(tid * 16 + i * 8192, R, C); const int Rb = Epi::PERM ? ((R & ~31) + perm32(R & 31)) : R;
        voffA[i] = (unsigned)(R * K + C) * 2u; voffB[i] = (unsigned)(Rb * K + C) * 2u; }
    const size_t kstep = (size_t)(BK * 2);
    const size_t hstep = (size_t)HALF * K * 2;
    const size_t tstep = 2 * hstep;
    const unsigned ldsw = (unsigned)wid * 1024u;
    const int aoff = lds_byte(wr * 64 + fr, fq * 8), boff = lds_byte(wc * 32 + fr, fq * 8);
#define PG8_SA(b, h) (((b) * 2 + (h)) * HTB)
#define PG8_SB(b, h) ((4 + (b) * 2 + (h)) * HTB)
#define PG8_STAGE(bufoff, gbase, voff) do { _Pragma("unroll") for (int _i = 0; _i < 2; ++_i) \
        __builtin_amdgcn_global_load_lds((const unsigned*)((const char*)(gbase) + (voff)[_i]), (PG8_LAS unsigned*)(lds + (bufoff) + ldsw + _i * 8192), 16, 0, 0); } while (0)
#define PG8_LDA(dst, b, h) do { _Pragma("unroll") for (int m = 0; m < 4; ++m) _Pragma("unroll") for (int k = 0; k < 2; ++k) dst[m][k] = *(const PG8_LAS bf16x8*)(lds + PG8_SA(b, h) + aoff + m * 2048 + k * 1024); } while (0)
#define PG8_LDB(dst, b, h) do { _Pragma("unroll") for (int n = 0; n < 2; ++n) _Pragma("unroll") for (int k = 0; k < 2; ++k) dst[n][k] = *(const PG8_LAS bf16x8*)(lds + PG8_SB(b, h) + boff + n * 2048 + k * 1024); } while (0)
#define PG8_MMA(ai, bj, At, Bt) do { __builtin_amdgcn_s_setprio(1); _Pragma("unroll") for (int m = 0; m < 4; ++m) _Pragma("unroll") for (int n = 0; n < 2; ++n) _Pragma("unroll") for (int k = 0; k < 2; ++k) \
        acc[ai][bj][m][n] = __builtin_amdgcn_mfma_f32_16x16x32_bf16(Bt[n][k], At[m][k], acc[ai][bj][m][n], 0, 0, 0); __builtin_amdgcn_s_setprio(0); } while (0)
#define PG8_WAIT_V(n) asm volatile("s_waitcnt vmcnt(" #n ")" ::: "memory")
#define PG8_WAIT_L(n) asm volatile("s_waitcnt lgkmcnt(" #n ")" ::: "memory")
#define PG8_BAR __builtin_amdgcn_s_barrier()
#define PG8_SCHED __builtin_amdgcn_sched_barrier(0)
    Unit cur, nxt; int ui = 0;
    if (!S.next(0, cur)) return;
    f32x4 acc[2][2][4][2];
#pragma unroll
    for (int a = 0; a < 2; ++a)
#pragma unroll
        for (int b = 0; b < 2; ++b)
#pragma unroll
            for (int m = 0; m < 4; ++m)
#pragma unroll
                for (int n = 0; n < 2; ++n) acc[a][b][m][n] = (f32x4){0.f, 0.f, 0.f, 0.f};
    bf16x8 At[4][2], B0[2][2], B1[2][2];
    const char* cA = (const char*)g.A + (size_t)cur.pm * tstep; const char* cB = (const char*)g.Bt + (size_t)cur.pn * tstep;
    S.a_ready(cur);
    if constexpr (SP2) {
        PG8_STAGE(PG8_SB(0, 0), cB, voffB); PG8_STAGE(PG8_SB(0, 1), cB + hstep, voffB); PG8_STAGE(PG8_SA(0, 0), cA, voffA); PG8_STAGE(PG8_SA(0, 1), cA + hstep, voffA);
        if (wr == 1) PG8_BAR;
        PG8_WAIT_V(2); PG8_BAR;
        PG8_STAGE(PG8_SB(1, 0), cB + kstep, voffB); PG8_STAGE(PG8_SA(1, 0), cA + kstep, voffA); PG8_STAGE(PG8_SB(1, 1), cB + hstep + kstep, voffB);
        PG8_WAIT_V(6); PG8_BAR;
    } else {
        PG8_STAGE(PG8_SB(0, 0), cB, voffB); PG8_STAGE(PG8_SA(0, 0), cA, voffA); PG8_STAGE(PG8_SB(0, 1), cB + hstep, voffB); PG8_STAGE(PG8_SA(0, 1), cA + hstep, voffA);
        if (wr == 1) PG8_BAR;
        PG8_WAIT_V(4); PG8_BAR;
        PG8_STAGE(PG8_SB(1, 0), cB + kstep, voffB); PG8_STAGE(PG8_SA(1, 0), cA + kstep, voffA); PG8_STAGE(PG8_SB(1, 1), cB + hstep + kstep, voffB);
        PG8_WAIT_V(6); PG8_BAR;
    }
    for (;;) {
        const bool has_next = S.next(ui + 1, nxt);
        const char* nA = has_next ? (const char*)g.A + (size_t)nxt.pm * tstep : cA; const char* nB = has_next ? (const char*)g.Bt + (size_t)nxt.pn * tstep : cB;
        for (int t = 0; t < nt; t += 2) {
            const bool last = (t == nt - 2);
            const char* a1 = cA + (size_t)(t + 1) * kstep;
            const char* a2 = last ? nA : cA + (size_t)(t + 2) * kstep; const char* b2 = last ? nB : cB + (size_t)(t + 2) * kstep;
            const char* a3 = a2 + kstep; const char* b3 = b2 + kstep;
            if (last && has_next) S.a_ready(nxt);
            if constexpr (SP2) {
            PG8_LDB(B0, 0, 0); PG8_LDB(B1, 0, 1); PG8_SCHED; PG8_LDA(At, 0, 0); PG8_STAGE(PG8_SA(1, 1), a1 + hstep, voffA);
            PG8_WAIT_V(8); PG8_WAIT_L(0); PG8_BAR; PG8_MMA(0, 0, At, B0); PG8_MMA(0, 1, At, B1); PG8_BAR; PG8_SCHED;
            PG8_LDA(At, 0, 1); PG8_STAGE(PG8_SB(0, 0), b2, voffB); PG8_STAGE(PG8_SB(0, 1), b2 + hstep, voffB); PG8_STAGE(PG8_SA(0, 0), a2, voffA);
            PG8_WAIT_V(8); PG8_WAIT_L(0); PG8_BAR; PG8_MMA(1, 0, At, B0); PG8_MMA(1, 1, At, B1); PG8_BAR; PG8_SCHED;
            PG8_LDB(B0, 1, 0); PG8_LDB(B1, 1, 1); PG8_SCHED; PG8_LDA(At, 1, 0); PG8_STAGE(PG8_SA(0, 1), a2 + hstep, voffA);
            PG8_WAIT_V(8); PG8_WAIT_L(0); PG8_BAR; PG8_MMA(0, 0, At, B0); PG8_MMA(0, 1, At, B1); PG8_BAR; PG8_SCHED;
            PG8_LDA(At, 1, 1); PG8_STAGE(PG8_SB(1, 0), b3, voffB); PG8_STAGE(PG8_SB(1, 1), b3 + hstep, voffB); PG8_STAGE(PG8_SA(1, 0), a3, voffA);
            PG8_WAIT_V(8); PG8_WAIT_L(0); PG8_BAR; PG8_MMA(1, 0, At, B0); PG8_MMA(1, 1, At, B1); PG8_BAR; PG8_SCHED;
            } else {
            PG8_LDB(B0, 0, 0); PG8_SCHED; PG8_LDA(At, 0, 0); PG8_STAGE(PG8_SA(1, 1), a1 + hstep, voffA);
            PG8_WAIT_L(8); PG8_BAR; PG8_WAIT_L(0); PG8_MMA(0, 0, At, B0); PG8_BAR; PG8_SCHED;
            PG8_LDB(B1, 0, 1); PG8_STAGE(PG8_SB(0, 0), b2, voffB);
            PG8_BAR; PG8_WAIT_L(0); PG8_MMA(0, 1, At, B1); PG8_BAR;
            PG8_LDA(At, 0, 1); PG8_STAGE(PG8_SA(0, 0), a2, voffA);
            PG8_BAR; PG8_WAIT_L(0); PG8_MMA(1, 0, At, B0); PG8_BAR; PG8_SCHED;
            PG8_STAGE(PG8_SB(0, 1), b2 + hstep, voffB);
            PG8_WAIT_V(6); PG8_BAR; PG8_MMA(1, 1, At, B1); PG8_BAR;
            PG8_LDB(B0, 1, 0); PG8_SCHED; PG8_LDA(At, 1, 0); PG8_STAGE(PG8_SA(0, 1), a2 + hstep, voffA);
            PG8_WAIT_L(8); PG8_BAR; PG8_WAIT_L(0); PG8_MMA(0, 0, At, B0); PG8_BAR; PG8_SCHED;
            PG8_LDB(B1, 1, 1); PG8_STAGE(PG8_SB(1, 0), b3, voffB);
            PG8_BAR; PG8_WAIT_L(0); PG8_MMA(0, 1, At, B1); PG8_BAR;
            PG8_LDA(At, 1, 1); PG8_STAGE(PG8_SA(1, 0), a3, voffA);
            PG8_BAR; PG8_WAIT_L(0); PG8_MMA(1, 0, At, B0); PG8_BAR; PG8_SCHED;
            PG8_STAGE(PG8_SB(1, 1), b3 + hstep, voffB);
            PG8_WAIT_V(6); PG8_BAR; PG8_MMA(1, 1, At, B1); PG8_BAR;
            }
        }
        if constexpr (ALIGN_EPI) { if (wr == 0) PG8_BAR; }
        if constexpr (!Epi::AFTER_DRAIN) { E(acc, cur, wr, wc, fr, fq); S.done(cur); }
        if (!has_next) break;
#pragma unroll
        for (int a = 0; a < 2; ++a)
#pragma unroll
            for (int b = 0; b < 2; ++b)
#pragma unroll
                for (int m = 0; m < 4; ++m)
#pragma unroll
                    for (int n = 0; n < 2; ++n) acc[a][b][m][n] = (f32x4){0.f, 0.f, 0.f, 0.f};
        cur = nxt; cA = nA; cB = nB; ++ui;
        if constexpr (ALIGN_EPI) { if (wr == 1) PG8_BAR; }
    }
    PG8_WAIT_V(0);
    if constexpr (!ALIGN_EPI) { if (wr == 0) PG8_BAR; }
    PG8_BAR;
    if constexpr (Epi::AFTER_DRAIN) { E.fused(acc, cur, wr, wc, fr, fq, lds, wid, lane); S.done(cur); }
#undef PG8_SA
#undef PG8_SB
#undef PG8_STAGE
#undef PG8_LDA
#undef PG8_LDB
#undef PG8_MMA
#undef PG8_WAIT_V
#undef PG8_WAIT_L
#undef PG8_BAR
#undef PG8_SCHED
}
}


#define LAS __attribute__((address_space(3)))
#define DI __device__ __forceinline__
__device__ __forceinline__ int bid() { int b = blockIdx.x; asm volatile("" : "+s"(b)); return b; }
typedef unsigned short bf16_t;
typedef short bf16x8 __attribute__((ext_vector_type(8)));
typedef float f32x4 __attribute__((ext_vector_type(4)));
typedef float f32x2 __attribute__((ext_vector_type(2)));
typedef float f32x16 __attribute__((ext_vector_type(16)));
typedef unsigned u32x4 __attribute__((ext_vector_type(4)));
typedef unsigned u32x2 __attribute__((ext_vector_type(2)));
typedef __bf16 bf16x2_t __attribute__((ext_vector_type(2)));

constexpr int BATCH = 2, SEQ = 8192, DM = 1024, CTXL = 256, FF = 4096;
constexpr int ML = BATCH * SEQ;
constexpr int MT = ML + BATCH * CTXL;
constexpr float EPS = 1e-6f;
constexpr float C2 = 0.125f * 1.4426950408889634f;
constexpr float LOG2E = 1.4426950408889634f;

constexpr size_t MiB = (size_t)1 << 20;
constexpr size_t WS_MODV = 0;
constexpr size_t WS_ROPE = 1 * MiB;
constexpr size_t WS_W = 3 * MiB;
constexpr size_t W_QKV0 = WS_W, W_O0 = WS_W + 3 * MiB, W_PW1 = WS_W + 5 * MiB, W_PW2 = WS_W + 9 * MiB, W_QKV2 = WS_W + 11 * MiB, W_O2 = WS_W + 17 * MiB,
                 W_QKV3 = WS_W + 19 * MiB, W_O3 = WS_W + 22 * MiB, W_UP = WS_W + 24 * MiB, W_DN = WS_W + 56 * MiB;
constexpr size_t WS_X = 91 * MiB;
constexpr size_t WS_XN = 157 * MiB;
constexpr size_t WS_BIG = 190 * MiB;
constexpr size_t WS_ATT = WS_BIG + 99 * MiB;
constexpr size_t WS_VT = 322 * MiB;
constexpr size_t WS_END = 355 * MiB;
constexpr int LDS_BYTES = 147456;

struct Params { const float* in[36]; float* out; unsigned char* ws; };

DI unsigned pk2(float lo, float hi) { f32x2 v = {lo, hi}; bf16x2_t b = __builtin_convertvector(v, bf16x2_t); return __builtin_bit_cast(unsigned, b); }
DI float bflo(unsigned w) { return __uint_as_float(w << 16); }
DI float bfhi(unsigned w) { return __uint_as_float(w & 0xffff0000u); }
DI float wave_sum(float v) {
#pragma unroll
    for (int o = 1; o < 64; o <<= 1) v += __shfl_xor(v, o);
    return v;
}
DI float half_swap_max(float v) { auto rr = __builtin_amdgcn_permlane32_swap(__float_as_uint(v), __float_as_uint(v), false, false); return fmaxf(__uint_as_float(rr[0]), __uint_as_float(rr[1])); }
DI float half_swap_sum(float v) { auto rr = __builtin_amdgcn_permlane32_swap(__float_as_uint(v), __float_as_uint(v), false, false); return __uint_as_float(rr[0]) + __uint_as_float(rr[1]); }

DI void transpose_item(const float* W, int K, int N, bf16_t* WT, int dst_row0, LAS float* scr, int k0, int n0, int lane) {
#pragma unroll
    for (int i = 0; i < 32; ++i) { const int kk = 2 * i + (lane >> 5); scr[kk * 33 + (lane & 31)] = W[(size_t)(k0 + kk) * N + n0 + (lane & 31)]; }
    asm volatile("s_waitcnt lgkmcnt(0)" ::: "memory");
    const int c = lane & 7;
#pragma unroll
    for (int j = 0; j < 4; ++j) { const int n = (lane >> 3) + 8 * j; const LAS float* s = scr + (8 * c) * 33 + n;
        u32x4 o; o.x = pk2(s[0 * 33], s[1 * 33]); o.y = pk2(s[2 * 33], s[3 * 33]); o.z = pk2(s[4 * 33], s[5 * 33]); o.w = pk2(s[6 * 33], s[7 * 33]);
        *(u32x4*)(WT + (size_t)(dst_row0 + n) * K + k0 + 8 * c) = o; }
    asm volatile("s_waitcnt lgkmcnt(0)" ::: "memory");
}

DI void prologue(const Params& P, LAS unsigned char* lds) {
    int tid_o = threadIdx.x; asm volatile("" : "+v"(tid_o)); const int tid = tid_o, lane = tid & 63, wid = tid >> 6;
    unsigned char* ws = P.ws;
    float* MODV = (float*)(ws + WS_MODV);
    {
        LAS float* sv = (LAS float*)lds; LAS float* red = sv + 3072;
        for (int i = tid; i < 3072; i += 512) { const int v = i >> 10, k = i & 1023; const float c = v < 2 ? P.in[1][v * 1024 + k] : P.in[3][k]; sv[i] = c / (1.0f + __expf(-c)); }
        __syncthreads();
        for (int item = bid(); item < 384; item += gridDim.x) {
            const int l = item / 96, cc = item % 96; const int col = cc * 64 + lane;
            const float* W = P.in[6] + (size_t)l * 1024 * 6144 + col;
            float a0 = 0.f, a1 = 0.f, a2 = 0.f;
#pragma unroll 32
            for (int kk = 0; kk < 128; ++kk) { const int k = wid * 128 + kk; const float w = W[(size_t)k * 6144]; a0 += sv[k] * w; a1 += sv[1024 + k] * w; a2 += sv[2048 + k] * w; }
            red[(wid * 3 + 0) * 64 + lane] = a0; red[(wid * 3 + 1) * 64 + lane] = a1; red[(wid * 3 + 2) * 64 + lane] = a2;
            __syncthreads();
            if (tid < 192) { const int v = tid >> 6; float s = 0.f;
#pragma unroll
                for (int w = 0; w < 8; ++w) s += red[(w * 3 + v) * 64 + lane];
                MODV[(size_t)(l * 3 + v) * 6144 + col] = s + P.in[7][l * 6144 + col]; }
            __syncthreads();
        }
    }
    if (bid() == 0 && tid == 0) {
        float s1 = 0.f, s2 = 0.f;
        for (int i = 0; i < 64; ++i) { s1 += P.in[25][i] * P.in[26][i]; s2 += P.in[27][i] * P.in[28][i]; }
        const float lam_init = 0.8f - 0.6f * 0.5488116360940264f;
        MODV[73728] = __expf(s1) - __expf(s2) + lam_init;
    }
    const int gw = bid() * 8 + wid, NGW = gridDim.x * 8;
    {
        f32x2* R = (f32x2*)(ws + WS_ROPE);
        for (int e = gw * 64 + lane; e < 8192 * 32; e += NGW * 64) { const int t = e >> 5, i = e & 31; const int j = i & 15; const float pos = (float)(i < 16 ? (t >> 6) : (t & 63));
            const float inv = 1.0f / exp2f((float)j * 0.83048202372184f); const float ang = pos * inv; R[e] = (f32x2){__cosf(ang), __sinf(ang)}; }
    }
    {
        LAS float* scr = (LAS float*)(lds + 32768 + wid * 8704);
        constexpr int NIT = 22528;
        for (int it = gw; it < NIT; it += NGW) {
            int r = it; const float* W; int K, N; bf16_t* WT; int mode = 0;
            if (r < 768) { W = P.in[10]; K = 1024; N = 1536; WT = (bf16_t*)(ws + W_QKV0); mode = 2; }
            else if ((r -= 768) < 512) { W = P.in[13]; K = 1024; N = 1024; WT = (bf16_t*)(ws + W_O0); }
            else if ((r -= 512) < 1024) { W = P.in[14]; K = 1024; N = 2048; WT = (bf16_t*)(ws + W_PW1); mode = 1; }
            else if ((r -= 1024) < 512) { W = P.in[20]; K = 1024; N = 1024; WT = (bf16_t*)(ws + W_PW2); }
            else if ((r -= 512) < 1536) { W = P.in[22]; K = 1024; N = 3072; WT = (bf16_t*)(ws + W_QKV2); mode = 2; }
            else if ((r -= 1536) < 512) { W = P.in[30]; K = 1024; N = 1024; WT = (bf16_t*)(ws + W_O2); }
            else if ((r -= 512) < 768) { W = P.in[31]; K = 1024; N = 1536; WT = (bf16_t*)(ws + W_QKV3); mode = 2; }
            else if ((r -= 768) < 512) { W = P.in[35]; K = 1024; N = 1024; WT = (bf16_t*)(ws + W_O3); }
            else if ((r -= 512) < 8192) { const int l = r >> 11; r &= 2047; W = P.in[8] + (size_t)l * 1024 * 4096; K = 1024; N = 4096; WT = (bf16_t*)(ws + W_UP) + (size_t)l * 4096 * 1024; }
            else { r -= 8192; const int l = r >> 11; r &= 2047; W = P.in[9] + (size_t)l * 4096 * 1024; K = 4096; N = 1024; WT = (bf16_t*)(ws + W_DN) + (size_t)l * 4096 * 1024; }
            const int nblk = N / 32, kb = r / nblk, nb = r % nblk, k0 = 64 * kb, n0 = 32 * nb;
            int dst = n0;
            if (mode == 1) { const int bj = n0 >> 10, j = n0 & 1023; dst = 256 * (j >> 7) + 128 * bj + (j & 127); }
            if (mode == 2) { const int c = n0 & 255; dst = (n0 & ~255) + 128 * ((c & 63) >> 5) + 32 * (c >> 6) + (c & 31); }
            transpose_item(W, K, N, WT, dst, scr, k0, n0, lane);
        }
    }
}

DI void norm_phase(const Params& P, int l, int which  , int M, int first) {
    int tid_o = threadIdx.x; asm volatile("" : "+v"(tid_o)); const int tid = tid_o, lane = tid & 63, wid = tid >> 6;
    const int gw = bid() * 8 + wid, NGW = gridDim.x * 8;
    float* X = (float*)(P.ws + WS_X); bf16_t* XN = (bf16_t*)(P.ws + WS_XN);
    const float* MODV = (const float*)(P.ws + WS_MODV);
    const float* g = P.in[which ? 5 : 4] + l * 1024;
    f32x4 gv[4];
#pragma unroll
    for (int j = 0; j < 4; ++j) gv[j] = *(const f32x4*)(g + 4 * lane + 256 * j);
    for (int rowa = gw; rowa < M; rowa += 2 * NGW) {
        f32x4 v[2][4]; float s[2]; int rows[2]; bool ok[2];
#pragma unroll
        for (int q = 0; q < 2; ++q) { const int row = rowa + q * NGW; rows[q] = row; ok[q] = row < M; s[q] = 0.f;
            const int rr = ok[q] ? row : rowa;
            const float* src = first ? (rr < ML ? P.in[0] + (size_t)rr * 1024 : P.in[2] + (size_t)(rr - ML) * 1024) : X + (size_t)rr * 1024;
#pragma unroll
            for (int j = 0; j < 4; ++j) v[q][j] = *(const f32x4*)(src + 4 * lane + 256 * j); }
#pragma unroll
        for (int q = 0; q < 2; ++q) {
#pragma unroll
            for (int j = 0; j < 4; ++j) s[q] += (v[q][j].x * v[q][j].x + v[q][j].y * v[q][j].y) + (v[q][j].z * v[q][j].z + v[q][j].w * v[q][j].w);
            s[q] = wave_sum(s[q]); }
#pragma unroll
        for (int q = 0; q < 2; ++q) if (ok[q]) { const int row = rows[q];
            const int rt = row < 8192 ? 0 : (row < 16384 ? 1 : 2);
            const float* mv = MODV + (size_t)(l * 3 + rt) * 6144 + which * 3072;
            if (first) {
#pragma unroll
                for (int j = 0; j < 4; ++j) *(f32x4*)(X + (size_t)row * 1024 + 4 * lane + 256 * j) = v[q][j];
            }
            const float rs = 1.0f / sqrtf(s[q] * (1.0f / 1024.0f) + EPS);
#pragma unroll
            for (int j = 0; j < 4; ++j) { const int c = 4 * lane + 256 * j; const f32x4 sh = *(const f32x4*)(mv + c), sc = *(const f32x4*)(mv + 1024 + c);
                const f32x4 y = (v[q][j] * rs) * gv[j] * (sc + 1.0f) + sh;
                u32x2 w; w.x = pk2(y.x, y.y); w.y = pk2(y.z, y.w); *(u32x2*)(XN + (size_t)row * 1024 + c) = w; } }
    }
}

DI void qk_post(const Params& P, bf16_t* QKV, int pitch, int NV, const float* gq, const float* gk) {
    int tid_o = threadIdx.x; asm volatile("" : "+v"(tid_o)); const int tid = tid_o, lane = tid & 63, wid = tid >> 6, sub = lane & 7, vl = lane >> 3;
    const int gw = bid() * 8 + wid, NGW = gridDim.x * 8;
    const f32x2* R = (const f32x2*)(P.ws + WS_ROPE);
    float gqv[8], gkv[8];
#pragma unroll
    for (int e = 0; e < 8; ++e) { gqv[e] = gq[sub * 8 + e]; gkv[e] = gk[sub * 8 + e]; }
    const int nit = (NV + 7) >> 3;
    for (int row = gw; row < MT; row += NGW) {
        bf16_t* rp = QKV + (size_t)row * pitch;
        const bool lat = row < ML; const int t = row & 8191;
        f32x2 cs[4];
        if (lat) {
#pragma unroll
            for (int pr = 0; pr < 4; ++pr) cs[pr] = R[t * 32 + sub * 4 + pr];
        } else {
#pragma unroll
            for (int pr = 0; pr < 4; ++pr) cs[pr] = (f32x2){1.0f, 0.0f};
        }
        for (int it = 0; it < nit; ++it) {
            const int vec = it * 8 + vl; const bool act = vec < NV;
            u32x4 raw = (u32x4){0u, 0u, 0u, 0u};
            if (act) raw = *(const u32x4*)(rp + vec * 64 + sub * 8);
            float x[8] = {bflo(raw.x), bfhi(raw.x), bflo(raw.y), bfhi(raw.y), bflo(raw.z), bfhi(raw.z), bflo(raw.w), bfhi(raw.w)};
            float ss = 0.f;
#pragma unroll
            for (int e = 0; e < 8; ++e) ss += x[e] * x[e];
            ss += __shfl_xor(ss, 1); ss += __shfl_xor(ss, 2); ss += __shfl_xor(ss, 4);
            const float rs = 1.0f / sqrtf(ss * (1.0f / 64.0f) + EPS);
            const bool isq = vec < 16; const float qs = isq ? C2 : 1.0f;
            float y[8];
#pragma unroll
            for (int e = 0; e < 8; ++e) y[e] = x[e] * rs * (isq ? gqv[e] : gkv[e]);
#pragma unroll
            for (int pr = 0; pr < 4; ++pr) { const float a = y[2 * pr], b = y[2 * pr + 1]; y[2 * pr] = (a * cs[pr].x - b * cs[pr].y) * qs; y[2 * pr + 1] = (a * cs[pr].y + b * cs[pr].x) * qs; }
            if (act) { u32x4 o; o.x = pk2(y[0], y[1]); o.y = pk2(y[2], y[3]); o.z = pk2(y[4], y[5]); o.w = pk2(y[6], y[7]); *(u32x4*)(rp + vec * 64 + sub * 8) = o; }
        }
    }
}
DI void v_transpose(const Params& P, LAS unsigned char* lds, const bf16_t* QKV, int pitch, int vcol0, int nvc) {
    int tid_o = threadIdx.x; asm volatile("" : "+v"(tid_o)); const int tid = tid_o, lane = tid & 63, wid = tid >> 6;
    const int gw = bid() * 8 + wid, NGW = gridDim.x * 8;
    bf16_t* Vt = (bf16_t*)(P.ws + WS_VT);
    LAS unsigned char* scr = lds + wid * 9216;
    const int ncb = nvc >> 6, nitems = (MT / 64) * ncb;
    for (int it = gw; it < nitems; it += NGW) {
        const int tb = it / ncb, cb = it % ncb; const int row0 = tb * 64, c0 = vcol0 + cb * 64;
#pragma unroll
        for (int i = 0; i < 8; ++i) { const int rr = i * 8 + (lane >> 3), ch = lane & 7; const u32x4 v = *(const u32x4*)(QKV + (size_t)(row0 + rr) * pitch + c0 + ch * 8); *(LAS u32x4*)(scr + rr * 144 + ch * 16) = v; }
        asm volatile("s_waitcnt lgkmcnt(0)" ::: "memory");
#pragma unroll
        for (int i = 0; i < 8; ++i) { const int c = i * 8 + (lane >> 3), t8 = (lane & 7) * 8;
            unsigned short h[8];
#pragma unroll
            for (int e = 0; e < 8; ++e) h[e] = *(const LAS unsigned short*)(scr + (t8 + e) * 144 + c * 2);
            u32x4 o; o.x = (unsigned)h[0] | ((unsigned)h[1] << 16); o.y = (unsigned)h[2] | ((unsigned)h[3] << 16); o.z = (unsigned)h[4] | ((unsigned)h[5] << 16); o.w = (unsigned)h[6] | ((unsigned)h[7] << 16);
            *(u32x4*)(Vt + (size_t)(cb * 64 + c) * MT + row0 + t8) = o; }
        asm volatile("s_waitcnt lgkmcnt(0)" ::: "memory");
    }
}

template <int DV, bool WINDOW, bool SUB>
DI void attn_core(LAS unsigned char* lds, const bf16_t* Qp, int qpitch, const bf16_t* Kp, int kpitch, const bf16_t* Vtp,
                  int rowA, int nA, int rowB, int nB, int qpos0, int kposB, float bref, f32x16 (&o)[DV / 32], float& m_out, float& l_out) {
    constexpr int NDB = DV / 32, NVJ = DV / 64, KBUF = 64 * 144, VBUF = DV * 144, VOFF = 4 * KBUF;
    constexpr bool NEGM = SUB && (DV == 64);
    constexpr bool FIXED = true;
    constexpr float THR = 8.0f;
    int tid_o = threadIdx.x; asm volatile("" : "+v"(tid_o)); const int tid = tid_o, lane = tid & 63, wid = tid >> 6, r32 = lane & 31, hi = lane >> 5;
    const int srow = tid >> 3, sch = tid & 7;
    const int NT = nA + nB;
    bf16x8 qr[4];
    { const bf16_t* qrow = Qp + (size_t)(wid * 32 + r32) * qpitch + hi * 8;
#pragma unroll
      for (int d0 = 0; d0 < 4; ++d0) qr[d0] = *(const bf16x8*)(qrow + d0 * 16); }
#pragma unroll
    for (int db = 0; db < NDB; ++db)
#pragma unroll
        for (int r = 0; r < 16; ++r) o[db][r] = 0.f;
    f32x16 negm;
#pragma unroll
    for (int r = 0; r < 16; ++r) negm[r] = SUB ? -bref : 0.f;
    float mref = SUB ? bref : 0.f, l = 0.f;
    const float INF = __builtin_inff();
    u32x4 kst[2], vst[2][NVJ];
#define TROW(tt) ((tt) < nA ? rowA + (tt) * 64 : rowB + ((tt) - nA) * 64)
#define LOADK(tt, st) do { const int r0_ = TROW(tt); kst[st] = *(const u32x4*)(Kp + (size_t)(r0_ + srow) * kpitch + sch * 8); } while (0)
#define LOADV(tt, st) do { const int r0_ = TROW(tt); _Pragma("unroll") for (int j_ = 0; j_ < NVJ; ++j_) vst[st][j_] = *(const u32x4*)(Vtp + (size_t)(j_ * 64 + srow) * MT + r0_ + sch * 8); } while (0)
#define STOREK(buf, st) do { *(LAS u32x4*)(lds + (buf) * KBUF + srow * 144 + sch * 16) = kst[st]; } while (0)
#define STOREV(buf, st) do { _Pragma("unroll") for (int j_ = 0; j_ < NVJ; ++j_) *(LAS u32x4*)(lds + VOFF + (buf) * VBUF + (j_ * 64 + srow) * 144 + sch * 16) = vst[st][j_]; } while (0)
    const int rho = (r32 & ~12) | ((r32 & 4) << 1) | ((r32 & 8) >> 1);
    const int koff = rho * 144 + hi * 16, voff = VOFF + r32 * 144 + hi * 16;
    const int qp = qpos0 + wid * 32 + r32;
#define QK(PA, PB, buf) do { const LAS unsigned char* kb_ = lds + (buf) * KBUF + koff; if (NEGM) { PA = negm; PB = negm; } else { _Pragma("unroll") for (int r = 0; r < 16; ++r) { PA[r] = 0.f; PB[r] = 0.f; } } \
        _Pragma("unroll") for (int d0 = 0; d0 < 4; ++d0) { const bf16x8 k0_ = *(const LAS bf16x8*)(kb_ + d0 * 32), k1_ = *(const LAS bf16x8*)(kb_ + 32 * 144 + d0 * 32); \
            PA = __builtin_amdgcn_mfma_f32_32x32x16_bf16(k0_, qr[d0], PA, 0, 0, 0); PB = __builtin_amdgcn_mfma_f32_32x32x16_bf16(k1_, qr[d0], PB, 0, 0, 0); } } while (0)
#define WNEED(t_) (!WINDOW || (t_) < nA || (kposB + ((t_) - nA) * 64 <= qpos0 + wid * 32 + 159 && kposB + ((t_) - nA) * 64 + 191 >= qpos0 + wid * 32))
#define BODY(PS0, PS1, PN0, PN1, tt, kbi, vbi) do { \
        if ((tt) + 1 < NT && WNEED((tt) + 1)) QK(PN0, PN1, kbi); \
        if (WNEED(tt)) { \
        if (WINDOW && (tt) >= nA) { const int kp0_ = kposB + ((tt) - nA) * 64 + 8 * hi - qp; \
            _Pragma("unroll") for (int r = 0; r < 16; ++r) { const int d_ = kp0_ + (r & 7) + 16 * (r >> 3); if (d_ > 128 || d_ < -128) PS0[r] = -1e30f; if (d_ + 32 > 128 || d_ + 32 < -128) PS1[r] = -1e30f; } } \
        if (!FIXED) { float mxa_ = __builtin_amdgcn_fmed3f(PS0[0], PS0[1], INF), mxb_ = __builtin_amdgcn_fmed3f(PS1[0], PS1[1], INF); \
        _Pragma("unroll") for (int r = 2; r < 16; ++r) { mxa_ = __builtin_amdgcn_fmed3f(mxa_, PS0[r], INF); mxb_ = __builtin_amdgcn_fmed3f(mxb_, PS1[r], INF); } \
        float mx_ = half_swap_max(__builtin_amdgcn_fmed3f(mxa_, mxb_, INF)); if (!NEGM) mx_ -= mref; \
        if ((tt) == 0 || __any(mx_ > THR)) { const float dl_ = ((tt) == 0) ? mx_ : (mx_ > 0.f ? mx_ : 0.f); mref += dl_; \
            if (NEGM) { _Pragma("unroll") for (int r = 0; r < 16; ++r) { PS0[r] -= dl_; PS1[r] -= dl_; PN0[r] -= dl_; PN1[r] -= dl_; negm[r] = -mref; } } \
            if ((tt) != 0) { const float al_ = __builtin_amdgcn_exp2f(-dl_); l *= al_; \
                _Pragma("unroll") for (int db = 0; db < NDB; ++db) _Pragma("unroll") for (int r = 0; r < 16; ++r) o[db][r] *= al_; } } } \
        float ls_ = 0.f; \
        _Pragma("unroll") for (int r = 0; r < 16; ++r) { PS0[r] = __builtin_amdgcn_exp2f((NEGM || !SUB) ? PS0[r] : PS0[r] - mref); PS1[r] = __builtin_amdgcn_exp2f((NEGM || !SUB) ? PS1[r] : PS1[r] - mref); ls_ += PS0[r] + PS1[r]; } \
        l += ls_; \
        bf16x8 pf_[4]; { u32x4 w_; \
          w_.x = pk2(PS0[0], PS0[1]); w_.y = pk2(PS0[2], PS0[3]); w_.z = pk2(PS0[4], PS0[5]); w_.w = pk2(PS0[6], PS0[7]); pf_[0] = __builtin_bit_cast(bf16x8, w_); \
          w_.x = pk2(PS0[8], PS0[9]); w_.y = pk2(PS0[10], PS0[11]); w_.z = pk2(PS0[12], PS0[13]); w_.w = pk2(PS0[14], PS0[15]); pf_[1] = __builtin_bit_cast(bf16x8, w_); \
          w_.x = pk2(PS1[0], PS1[1]); w_.y = pk2(PS1[2], PS1[3]); w_.z = pk2(PS1[4], PS1[5]); w_.w = pk2(PS1[6], PS1[7]); pf_[2] = __builtin_bit_cast(bf16x8, w_); \
          w_.x = pk2(PS1[8], PS1[9]); w_.y = pk2(PS1[10], PS1[11]); w_.z = pk2(PS1[12], PS1[13]); w_.w = pk2(PS1[14], PS1[15]); pf_[3] = __builtin_bit_cast(bf16x8, w_); } \
        { const LAS unsigned char* vb_ = lds + voff + (vbi) * VBUF; \
            \
          _Pragma("unroll") for (int dp = 0; dp < NDB / 2; ++dp) { \
            _Pragma("unroll") for (int sh = 0; sh < 2; ++sh) { bf16x8 va_[2], vb2_[2]; \
              _Pragma("unroll") for (int s = 0; s < 2; ++s) { va_[s] = *(const LAS bf16x8*)(vb_ + (2 * dp) * 32 * 144 + (2 * sh + s) * 32); vb2_[s] = *(const LAS bf16x8*)(vb_ + (2 * dp + 1) * 32 * 144 + (2 * sh + s) * 32); } \
              _Pragma("unroll") for (int s = 0; s < 2; ++s) { o[2 * dp] = __builtin_amdgcn_mfma_f32_32x32x16_bf16(va_[s], pf_[2 * sh + s], o[2 * dp], 0, 0, 0); \
                                                               o[2 * dp + 1] = __builtin_amdgcn_mfma_f32_32x32x16_bf16(vb2_[s], pf_[2 * sh + s], o[2 * dp + 1], 0, 0, 0); } } \
            if (DV > 64) __builtin_amdgcn_sched_barrier(0); } } \
        } } while (0)
    f32x16 pa0, pa1, pb0, pb1;
    LOADK(0, 0); LOADK(1, 1); LOADV(0, 0); LOADV(1, 1); STOREK(0, 0); STOREK(1, 1); STOREV(0, 0); STOREV(1, 1); LOADK(2, 0); __syncthreads();
    QK(pa0, pa1, 0);
    STOREK(2, 0);
    __syncthreads();
#pragma unroll
    for (int r = 0; r < 16; ++r) { pb0[r] = 0.f; pb1[r] = 0.f; }
    for (int t = 0; t < NT; t += 2) {
        if (t + 3 < NT) LOADK(t + 3, 0);
        if (t + 4 < NT) LOADK(t + 4, 1);
        if (t + 2 < NT) LOADV(t + 2, 0);
        if (t + 3 < NT) LOADV(t + 3, 1);
        BODY(pa0, pa1, pb0, pb1, t, (t + 1) & 3, t & 3);
        BODY(pb0, pb1, pa0, pa1, t + 1, (t + 2) & 3, (t + 1) & 3);
        if (t + 3 < NT) STOREK((t + 3) & 3, 0);
        if (t + 4 < NT) STOREK((t + 4) & 3, 1);
        if (t + 2 < NT) STOREV((t + 2) & 3, 0);
        if (t + 3 < NT) STOREV((t + 3) & 3, 1);
        __syncthreads();
    }
#undef BODY
#undef WNEED
#undef TROW
#undef LOADK
#undef LOADV
#undef STOREK
#undef STOREV
#undef QK
    m_out = mref; l_out = half_swap_sum(l);
}

template <bool WINDOW>
DI float rowmax_core(LAS unsigned char* lds, const bf16_t* Qp, int qpitch, const bf16_t* Kp, int kpitch, int rowA, int nA, int rowB, int nB, int qpos0, int kposB) {
    int tid_o = threadIdx.x; asm volatile("" : "+v"(tid_o)); const int tid = tid_o, lane = tid & 63, wid = tid >> 6, r32 = lane & 31, hi = lane >> 5;
    const int srow = tid >> 3, sch = tid & 7; const int NT = nA + nB;
    bf16x8 qr[4];
    { const bf16_t* qrow = Qp + (size_t)(wid * 32 + r32) * qpitch + hi * 8;
#pragma unroll
      for (int d0 = 0; d0 < 4; ++d0) qr[d0] = *(const bf16x8*)(qrow + d0 * 16); }
    const int rho = (r32 & ~12) | ((r32 & 4) << 1) | ((r32 & 8) >> 1);
    const int koff = rho * 144 + hi * 16; const int qp = qpos0 + wid * 32 + r32;
    float mx = -1e30f;
    for (int t = 0; t < NT; ++t) {
        const int r0 = t < nA ? rowA + t * 64 : rowB + (t - nA) * 64;
        const u32x4 kv = *(const u32x4*)(Kp + (size_t)(r0 + srow) * kpitch + sch * 8);
        __syncthreads();
        *(LAS u32x4*)(lds + srow * 144 + sch * 16) = kv;
        __syncthreads();
        f32x16 p0, p1;
#pragma unroll
        for (int r = 0; r < 16; ++r) { p0[r] = 0.f; p1[r] = 0.f; }
#pragma unroll
        for (int d0 = 0; d0 < 4; ++d0) { const bf16x8 k0 = *(const LAS bf16x8*)(lds + koff + d0 * 32), k1 = *(const LAS bf16x8*)(lds + koff + 32 * 144 + d0 * 32);
            p0 = __builtin_amdgcn_mfma_f32_32x32x16_bf16(k0, qr[d0], p0, 0, 0, 0); p1 = __builtin_amdgcn_mfma_f32_32x32x16_bf16(k1, qr[d0], p1, 0, 0, 0); }
        if (WINDOW && t >= nA) { const int kp0 = kposB + (t - nA) * 64 + 8 * hi - qp;
#pragma unroll
            for (int r = 0; r < 16; ++r) { const int d = kp0 + (r & 7) + 16 * (r >> 3); if (d > 128 || d < -128) p0[r] = -1e30f; if (d + 32 > 128 || d + 32 < -128) p1[r] = -1e30f; } }
#pragma unroll
        for (int r = 0; r < 16; ++r) mx = fmaxf(mx, fmaxf(p0[r], p1[r]));
    }
    __syncthreads();
    return half_swap_max(mx);
}

DI float score_bound(const float* gq, const float* gk) {
    int lane = threadIdx.x & 63; asm volatile("" : "+v"(lane));
    float a = fabsf(gq[lane]), b = fabsf(gk[lane]);
#pragma unroll
    for (int o = 1; o < 64; o <<= 1) { a = fmaxf(a, __shfl_xor(a, o)); b = fmaxf(b, __shfl_xor(b, o)); }
    const float bound = 64.0f * a * b * C2 * 1.02f + 0.25f;
    const float r = (bound < 40.0f) ? bound : -1.0f;
    return __uint_as_float(__builtin_amdgcn_readfirstlane(__float_as_uint(r)));
}

template <bool WINDOW>
DI void attn_gqa_phase(const Params& P, LAS unsigned char* lds, const float* sink, const float* gq, const float* gk) {
    int tid_o = threadIdx.x; asm volatile("" : "+v"(tid_o)); const int tid = tid_o, lane = tid & 63, wid = tid >> 6, r32 = lane & 31, hi = lane >> 5;
    const bf16_t* QKV = (const bf16_t*)(P.ws + WS_BIG); const bf16_t* Vt = (const bf16_t*)(P.ws + WS_VT); bf16_t* ATT = (bf16_t*)(P.ws + WS_ATT);
    const int NU = WINDOW ? 1024 : 1056;
    const float bref = score_bound(gq, gk);
    for (int L = bid(); L < NU; L += gridDim.x) {
        int b, hq, qrow0, rowA, nA, rowB, nB, qpos0 = 0, kposB = 0;
        if (L < 1024) { const int combo = L & 7, rest = L >> 3; b = combo >> 2; const int kvh = combo & 3; hq = kvh * 4 + (rest >> 5); const int qb = rest & 31;
            qrow0 = b * SEQ + qb * 256; rowA = ML + b * CTXL; nA = 4;
            if (WINDOW) { int s = qb * 256 - 128; if (s < 0) s = 0; int e = qb * 256 + 384; if (e > SEQ) e = SEQ; rowB = b * SEQ + s; nB = (e - s) >> 6; qpos0 = qb * 256; kposB = s; }
            else { rowB = b * SEQ; nB = SEQ / 64; } }
        else { const int j = L - 1024; b = j >> 4; hq = j & 15; qrow0 = ML + b * CTXL; rowA = qrow0; nA = 4; rowB = 0; nB = 0; }
        const int kvh = hq >> 2;
        f32x16 o[2]; float m, l;
        if (bref >= 0.f) attn_core<64, WINDOW, false>(lds, QKV + (size_t)qrow0 * 1536 + hq * 64, 1536, QKV + 1024 + kvh * 64, 1536, Vt + (size_t)(kvh * 64) * MT, rowA, nA, rowB, nB, qpos0, kposB, 0.f, o, m, l);
        else { const float mr = rowmax_core<WINDOW>(lds, QKV + (size_t)qrow0 * 1536 + hq * 64, 1536, QKV + 1024 + kvh * 64, 1536, rowA, nA, rowB, nB, qpos0, kposB);
            attn_core<64, WINDOW, true>(lds, QKV + (size_t)qrow0 * 1536 + hq * 64, 1536, QKV + 1024 + kvh * 64, 1536, Vt + (size_t)(kvh * 64) * MT, rowA, nA, rowB, nB, qpos0, kposB, mr, o, m, l); }
        if (WINDOW) l += __builtin_amdgcn_exp2f(sink[hq] * LOG2E - m);
        const float inv = 1.0f / l;
        bf16_t* op = ATT + (size_t)(qrow0 + wid * 32 + r32) * 1024 + hq * 64 + 4 * hi;
#pragma unroll
        for (int db = 0; db < 2; ++db)
#pragma unroll
            for (int g = 0; g < 4; ++g) { u32x2 w; w.x = pk2(o[db][4 * g] * inv, o[db][4 * g + 1] * inv); w.y = pk2(o[db][4 * g + 2] * inv, o[db][4 * g + 3] * inv); *(u32x2*)(op + 32 * db + 8 * g) = w; }
    }
}

DI void attn_diff_phase(const Params& P, LAS unsigned char* lds) {
    const bf16_t* QKV = (const bf16_t*)(P.ws + WS_BIG); const bf16_t* Vt = (const bf16_t*)(P.ws + WS_VT); bf16_t* ATT = (bf16_t*)(P.ws + WS_ATT);
    const float lam = ((const float*)(P.ws + WS_MODV))[73728];
    const float lam_init = 0.8f - 0.6f * 0.5488116360940264f;
    const float* sg = P.in[29];
    const float bref = score_bound(P.in[23], P.in[24]);
    for (int L = bid(); L < 528; L += gridDim.x) {
        int b, h, qrow0, rowA, nA, rowB, nB;
        if (L < 512) { const int combo = L & 7, rest = L >> 3; const int pair = combo * 2 + (rest >> 5), qb = rest & 31; b = pair >> 3; h = pair & 7;
            qrow0 = b * SEQ + qb * 256; rowA = ML + b * CTXL; nA = 4; rowB = b * SEQ; nB = SEQ / 64; }
        else { const int j = L - 512; b = j >> 3; h = j & 7; qrow0 = ML + b * CTXL; rowA = qrow0; nA = 4; rowB = 0; nB = 0; }
        f32x16 o[4]; float m, l;
#pragma unroll 1
        for (int comp = 0; comp < 2; ++comp) {
            if (bref >= 0.f) attn_core<128, false, false>(lds, QKV + (size_t)qrow0 * 3072 + h * 128 + comp * 64, 3072, QKV + 1024 + h * 128 + comp * 64, 3072, Vt + (size_t)(h * 128) * MT, rowA, nA, rowB, nB, 0, 0, 0.f, o, m, l);
            else { const float mr = rowmax_core<false>(lds, QKV + (size_t)qrow0 * 3072 + h * 128 + comp * 64, 3072, QKV + 1024 + h * 128 + comp * 64, 3072, rowA, nA, rowB, nB, 0, 0);
                attn_core<128, false, true>(lds, QKV + (size_t)qrow0 * 3072 + h * 128 + comp * 64, 3072, QKV + 1024 + h * 128 + comp * 64, 3072, Vt + (size_t)(h * 128) * MT, rowA, nA, rowB, nB, 0, 0, mr, o, m, l); }
            int tid_p = threadIdx.x; asm volatile("" : "+v"(tid_p)); const int lane = tid_p & 63, wid = tid_p >> 6, r32 = lane & 31, hi = lane >> 5;
            float* stash = (float*)(P.ws + WS_XN) + ((size_t)(bid() * 8 + wid) * 64 + lane) * 64;
            if (comp == 0) { const float inv = 1.0f / l;
#pragma unroll
                for (int db = 0; db < 4; ++db)
#pragma unroll
                    for (int g = 0; g < 4; ++g) *(f32x4*)(stash + db * 16 + 4 * g) = (f32x4){o[db][4 * g] * inv, o[db][4 * g + 1] * inv, o[db][4 * g + 2] * inv, o[db][4 * g + 3] * inv};
            } else { const float inv = lam / l; float ss = 0.f;
#pragma unroll
                for (int db = 0; db < 4; ++db)
#pragma unroll
                    for (int g = 0; g < 4; ++g) { const f32x4 s0 = *(const f32x4*)(stash + db * 16 + 4 * g);
#pragma unroll
                        for (int e = 0; e < 4; ++e) { const float v = s0[e] - o[db][4 * g + e] * inv; o[db][4 * g + e] = v; ss += v * v; } }
                ss = half_swap_sum(ss);
                const float rs = (1.0f - lam_init) / sqrtf(ss * (1.0f / 128.0f) + EPS);
                bf16_t* op = ATT + (size_t)(qrow0 + wid * 32 + r32) * 1024 + h * 128 + 4 * hi;
#pragma unroll
                for (int db = 0; db < 4; ++db)
#pragma unroll
                    for (int g = 0; g < 4; ++g) { const f32x4 gg = *(const f32x4*)(sg + 32 * db + 8 * g + 4 * hi);
                        u32x2 w; w.x = pk2(o[db][4 * g] * rs * gg.x, o[db][4 * g + 1] * rs * gg.y); w.y = pk2(o[db][4 * g + 2] * rs * gg.z, o[db][4 * g + 3] * rs * gg.w); *(u32x2*)(op + 32 * db + 8 * g) = w; }
            }
        }
    }
}

DI void conv_phase(const Params& P, LAS unsigned char* lds, const bf16_t* U, bf16_t* OUT) {
    int tid_o = threadIdx.x; asm volatile("" : "+v"(tid_o)); const int tid = tid_o, lane = tid & 63, wid = tid >> 6;
    const int c0 = 2 * tid;
    float w0[31], w1[31];
#pragma unroll
    for (int j = 0; j < 31; ++j) { const f32x2 w = *(const f32x2*)(P.in[16] + j * 1024 + c0); w0[j] = w.x; w1[j] = w.y; }
    const f32x2 bdw = *(const f32x2*)(P.in[17] + c0), lng = *(const f32x2*)(P.in[18] + c0), lnb = *(const f32x2*)(P.in[19] + c0);
    LAS float* red = (LAS float*)(lds + 62 * 2048);
    for (int item = bid(); item < MT / 32; item += gridDim.x) {
        const int tok0 = item * 32; int s0, s1;
        if (tok0 < ML) { s0 = (tok0 >> 13) << 13; s1 = s0 + SEQ; } else { s0 = ML + (((tok0 - ML) >> 8) << 8); s1 = s0 + CTXL; }
        for (int ci = tid; ci < 62 * 128; ci += 512) { const int rr = ci >> 7, ch = ci & 127; const int tk = tok0 - 15 + rr;
            u32x4 v = (u32x4){0u, 0u, 0u, 0u};
            if (tk >= s0 && tk < s1) v = *(const u32x4*)(U + (size_t)tk * 1024 + ch * 8);
            *(LAS u32x4*)(lds + rr * 2048 + ch * 16) = v; }
        __syncthreads();
        for (int tg = 0; tg < 8; ++tg) {
            float a0[4], a1[4];
#pragma unroll
            for (int i = 0; i < 4; ++i) { a0[i] = bdw.x; a1[i] = bdw.y; }
            const LAS unsigned char* base = lds + (tg * 4) * 2048 + c0 * 2;
#pragma unroll
            for (int rr = 0; rr < 34; ++rr) { const unsigned u2 = *(const LAS unsigned*)(base + rr * 2048); const float x0 = bflo(u2), x1 = bfhi(u2);
#pragma unroll
                for (int i = 0; i < 4; ++i) { const int j = rr - i; if (j >= 0 && j <= 30) { a0[i] += w0[j] * x0; a1[i] += w1[j] * x1; } } }
            float st[8];
#pragma unroll
            for (int i = 0; i < 4; ++i) { st[2 * i] = wave_sum(a0[i] + a1[i]); st[2 * i + 1] = wave_sum(a0[i] * a0[i] + a1[i] * a1[i]); }
            LAS float* rb = red + (tg & 1) * 64;
            if (lane == 0) {
#pragma unroll
                for (int i = 0; i < 8; ++i) rb[wid * 8 + i] = st[i];
            }
            __syncthreads();
#pragma unroll
            for (int i = 0; i < 4; ++i) { float s = 0.f, q = 0.f;
#pragma unroll
                for (int w = 0; w < 8; ++w) { s += rb[w * 8 + 2 * i]; q += rb[w * 8 + 2 * i + 1]; }
                const float mean = s * (1.0f / 1024.0f); float var = q * (1.0f / 1024.0f) - mean * mean; var = var > 0.f ? var : 0.f;
                const float rs = 1.0f / sqrtf(var + EPS);
                float y0 = (a0[i] - mean) * rs * lng.x + lnb.x, y1 = (a1[i] - mean) * rs * lng.y + lnb.y;
                y0 = y0 / (1.0f + __expf(-y0)); y1 = y1 / (1.0f + __expf(-y1));
                *(unsigned*)(OUT + (size_t)(tok0 + tg * 4 + i) * 1024 + c0) = pk2(y0, y1); }
        }
        __syncthreads();
    }
}


template <int NB, class F>
DI void small_gemm(LAS unsigned char* lds, const bf16_t* A, int lda, const bf16_t* Bt, int ldb, int N, int KC, int rot, const F& f) {
    constexpr int ABUF = 64 * 144, BBUF = 128 * NB * 144, BOFF = 2 * ABUF;
    int tid_o = threadIdx.x; asm volatile("" : "+v"(tid_o)); const int tid = tid_o, lane = tid & 63, wid = tid >> 6, r32 = lane & 31, hi = lane >> 5, wr = wid >> 2, wc = wid & 3;
    const int srow = tid >> 3, sch = tid & 7;
    const int G = gridDim.x; const int nct = N / (128 * NB), nitems = 8 * nct * KC;
    int first = (int)bid() - rot; if (first < 0) first += G;
    const int aoff = (32 * wr + r32) * 144 + hi * 16, boff = BOFF + (32 * wc + r32) * 144 + hi * 16;
    for (int it = first; it < nitems; it += G) {
        const int kc = it % KC, t2 = it / KC, rt = t2 & 7, ct = t2 >> 3;
        const bf16_t* Ap = A + (size_t)(rt * 64 + srow) * lda + kc * 1024 + sch * 8;
        const bf16_t* Bp = Bt + (size_t)(ct * 128 * NB + srow) * ldb + kc * 1024 + sch * 8;
        f32x16 acc[NB];
#pragma unroll
        for (int nb = 0; nb < NB; ++nb)
#pragma unroll
            for (int r = 0; r < 16; ++r) acc[nb][r] = 0.f;
#define SG_BAR() do { asm volatile("s_waitcnt lgkmcnt(0)" ::: "memory"); __builtin_amdgcn_s_barrier(); asm volatile("" ::: "memory"); } while (0)
        u32x4 ast[4], bst[4][2 * NB];
#define SG_LOAD(ks, st) do { ast[st] = *(const u32x4*)(Ap + (ks) * 64); _Pragma("unroll") for (int j_ = 0; j_ < 2 * NB; ++j_) bst[st][j_] = *(const u32x4*)(Bp + (size_t)(j_ * 64) * ldb + (ks) * 64); } while (0)
#define SG_STORE(buf, st) do { *(LAS u32x4*)(lds + (buf) * ABUF + srow * 144 + sch * 16) = ast[st]; \
        _Pragma("unroll") for (int j_ = 0; j_ < 2 * NB; ++j_) *(LAS u32x4*)(lds + BOFF + (buf) * BBUF + (j_ * 64 + srow) * 144 + sch * 16) = bst[st][j_]; } while (0)
        SG_LOAD(0, 0); SG_LOAD(1, 1); SG_LOAD(2, 2); SG_LOAD(3, 3); SG_STORE(0, 0); SG_BAR();
        for (int k4 = 0; k4 < 16; k4 += 4) {
#pragma unroll
            for (int d = 0; d < 4; ++d) { const int ks = k4 + d; const int buf = d & 1;
                if (ks + 4 < 16) SG_LOAD(ks + 4, d);
#pragma unroll
                for (int kk = 0; kk < 4; ++kk) { const bf16x8 a = *(const LAS bf16x8*)(lds + buf * ABUF + aoff + kk * 32);
#pragma unroll
                    for (int nb = 0; nb < NB; ++nb) { const bf16x8 b = *(const LAS bf16x8*)(lds + buf * BBUF + boff + nb * 128 * 144 + kk * 32); acc[nb] = __builtin_amdgcn_mfma_f32_32x32x16_bf16(b, a, acc[nb], 0, 0, 0); } }
                if (ks + 1 < 16) SG_STORE(buf ^ 1, (d + 1) & 3);
                SG_BAR();
            }
        }
#undef SG_BAR
#undef SG_LOAD
#undef SG_STORE
        f(rt * 64 + 32 * wr + r32, ct, kc, wc, hi, acc);
    }
}
struct FSt { bf16_t* O; int ldc; int act;
    DI void operator()(int row, int ct, int kc, int wc, int hi, const f32x16 (&acc)[1]) const {
#pragma unroll
        for (int g = 0; g < 4; ++g) { float v[4];
#pragma unroll
            for (int e = 0; e < 4; ++e) { v[e] = acc[0][4 * g + e]; if (act == 2) { v[e] = v[e] > 0.f ? v[e] : 0.f; v[e] *= v[e]; } }
            u32x2 w; w.x = pk2(v[0], v[1]); w.y = pk2(v[2], v[3]); *(u32x2*)(O + (size_t)row * ldc + ct * 128 + 32 * wc + 8 * g + 4 * hi) = w; } } };
struct FGlu { bf16_t* O; const float* bias;
    DI void operator()(int row, int ct, int kc, int wc, int hi, const f32x16 (&acc)[2]) const {
#pragma unroll
        for (int g = 0; g < 4; ++g) { const int ch = ct * 128 + 32 * wc + 8 * g + 4 * hi; const f32x4 ba = *(const f32x4*)(bias + ch), bg = *(const f32x4*)(bias + 1024 + ch);
            float r[4];
#pragma unroll
            for (int e = 0; e < 4; ++e) r[e] = (acc[0][4 * g + e] + ba[e]) / (1.0f + __expf(-(acc[1][4 * g + e] + bg[e])));
            u32x2 w; w.x = pk2(r[0], r[1]); w.y = pk2(r[2], r[3]); *(u32x2*)(O + (size_t)row * 1024 + ch) = w; } } };
struct FRes { float* X; const float* gate; const float* bias; int atomic;
    DI void operator()(int row, int ct, int kc, int wc, int hi, const f32x16 (&acc)[1]) const {
#pragma unroll
        for (int g = 0; g < 4; ++g) { const int c = ct * 128 + 32 * wc + 8 * g + 4 * hi;
            float* p = X + (size_t)row * 1024 + c; const f32x4 gv = *(const f32x4*)(gate + c);
            f32x4 val = (f32x4){acc[0][4 * g], acc[0][4 * g + 1], acc[0][4 * g + 2], acc[0][4 * g + 3]}; if (bias && kc == 0) val = val + *(const f32x4*)(bias + c);
            val = val * gv;
            if (atomic) {
#pragma unroll
                for (int e = 0; e < 4; ++e) unsafeAtomicAdd(p + e, val[e]);
            } else { *(f32x4*)p = *(const f32x4*)p + val; } } } };
struct FQkv { bf16_t* O; int pitch; int nk; const float* gq; const float* gk; bf16_t* Vt; float qscale;
    DI void operator()(int row, int ct, int kc, int wc, int hi, const f32x16 (&acc)[2]) const {
        if (ct < 4 + nk) { const bool isq = ct < 4; const float* g = isq ? gq : gk;
            float ss = 0.f;
#pragma unroll
            for (int r = 0; r < 16; ++r) ss += acc[0][r] * acc[0][r] + acc[1][r] * acc[1][r];
            ss = half_swap_sum(ss);
            const float rs = (isq ? qscale : 1.0f) / sqrtf(ss * (1.0f / 64.0f) + EPS);
#pragma unroll
            for (int bj = 0; bj < 2; ++bj)
#pragma unroll
                for (int gi = 0; gi < 4; ++gi) { const int d0 = 32 * bj + 8 * gi + 4 * hi; const f32x4 gg = *(const f32x4*)(g + d0);
                    u32x2 w; w.x = pk2(acc[bj][4 * gi] * rs * gg[0], acc[bj][4 * gi + 1] * rs * gg[1]); w.y = pk2(acc[bj][4 * gi + 2] * rs * gg[2], acc[bj][4 * gi + 3] * rs * gg[3]);
                    *(u32x2*)(O + (size_t)row * pitch + ct * 256 + wc * 64 + d0) = w; }
        } else { const int vc0 = (ct - 4 - nk) * 256 + wc * 64 + 4 * hi;
#pragma unroll
            for (int bj = 0; bj < 2; ++bj)
#pragma unroll
                for (int r = 0; r < 16; ++r) { const int vc = vc0 + 32 * bj + (r & 3) + 8 * (r >> 2); const unsigned w = pk2(acc[bj][r], 0.f);
                    Vt[(size_t)vc * MT + row] = (bf16_t)(w & 0xffffu); } } } };

#ifndef PHM
#define PHM 0xffff
#endif
#define EN(k) ((PHM >> (k)) & 1)
#ifndef DBL
#define DBL 0
#endif
#define DB(k) ((DBL >> (k)) & 1)
template <class Epi> DI void run_gemm(LAS unsigned char* lds, const bf16_t* A, const bf16_t* Bt, int M, int N, int K, const Epi& E) {
    pg8::Gemm g{A, Bt, M, N, K}; pg8::StaticOrder S; S.init(M, N, (int)gridDim.x, (int)bid());
    pg8::gemm_phase<Epi, pg8::StaticOrder, true, true>(lds, g, S, E);
}

#define XB_TMO      128
#define XB_XCNT(j)  (256  + 64 * (j))
#define XB_XSUB(j)  (1280 + 64 * (j))
#define XB_XGEN(j)  (2304 + 64 * (j))
#define XB_TOP      3328
#define XB_TOPGEN   3392
#define XCD_BAR_WORDS 3456
#define XB_SPIN_CAP (1u << 18)

__device__ __forceinline__ unsigned xb_ld(unsigned* p)              { return __hip_atomic_load(p, __ATOMIC_RELAXED, __HIP_MEMORY_SCOPE_AGENT); }
__device__ __forceinline__ unsigned xb_add(unsigned* p, unsigned v) { return __hip_atomic_fetch_add(p, v, __ATOMIC_RELAXED, __HIP_MEMORY_SCOPE_AGENT); }
__device__ __forceinline__ unsigned xb_xcc_id() { return (unsigned)__builtin_amdgcn_s_getreg((3 << 11) | 20) & 0xFu; }
#define XB_SPIN(cond, bar) do { unsigned _sp = 0; while (cond) { __builtin_amdgcn_s_sleep(1); \
    if ((++_sp & 255u) == 0u) { if (xb_ld(&(bar)[XB_TMO])) break; if (_sp > XB_SPIN_CAP) { atomicAdd(&(bar)[XB_TMO], 1u); break; } } } } while (0)

struct XcdBarrier {
    unsigned* bar; unsigned x;
    volatile LAS unsigned* st;
};

__device__ __forceinline__ XcdBarrier xcd_barrier_post(unsigned* bar, volatile LAS unsigned* st) {
    XcdBarrier b; b.bar = bar; b.x = xb_xcc_id(); b.st = st;
    if (threadIdx.x == 0) (void)xb_add(&bar[XB_XCNT(b.x)], 1u);
    return b;
}
__device__ __forceinline__ void xcd_barrier_complete(unsigned* bar, unsigned x, unsigned& nloc, unsigned& nx) {
    const unsigned G = gridDim.x * gridDim.y * gridDim.z;
    unsigned sum, cnt, mine, sp = 0u;
    for (;;) {
        sum = 0u; cnt = 0u; mine = 0u;
#pragma unroll
        for (unsigned j = 0; j < 16; ++j) { const unsigned c = xb_ld(&bar[XB_XCNT(j)]); sum += c; cnt += (c > 0u) ? 1u : 0u; mine = (j == x) ? c : mine; }
        if (sum == G) break;
        __builtin_amdgcn_s_sleep(1);
        if ((++sp & 255u) == 0u) { if (xb_ld(&bar[XB_TMO])) break; if (sp > XB_SPIN_CAP) { atomicAdd(&bar[XB_TMO], 1u); break; } }
    }
    nloc = mine > 0u ? mine : 1u; nx = cnt > 0u ? cnt : 1u;
}

__device__ __forceinline__ void xcd_barrier(const XcdBarrier& b) {
    asm volatile("s_waitcnt vmcnt(0)" ::: "memory");
    __syncthreads();
    if (threadIdx.x == 0) {
        unsigned* bar = b.bar;
        __builtin_amdgcn_s_waitcnt(0);
        unsigned nloc = b.st[0], nx = b.st[1];
        if (nloc == 0u) { xcd_barrier_complete(bar, b.x, nloc, nx); b.st[0] = nloc; b.st[1] = nx; }
        const unsigned old = xb_add(&bar[XB_XSUB(b.x)], 1u);
        const unsigned gen = old / nloc;
        if (old + 1u == (gen + 1u) * nloc) {
            __builtin_amdgcn_fence(__ATOMIC_RELEASE, "agent");
            asm volatile("s_waitcnt vmcnt(0)" ::: "memory");
            const unsigned og = xb_add(&bar[XB_TOP], 1u);
            const unsigned tg = og / nx;
            if (og + 1u == (tg + 1u) * nx) xb_add(&bar[XB_TOPGEN], 1u);
            else XB_SPIN(xb_ld(&bar[XB_TOPGEN]) == tg, bar);
            __builtin_amdgcn_fence(__ATOMIC_ACQUIRE, "agent");
            xb_add(&bar[XB_XGEN(b.x)], 1u);
            asm volatile("s_waitcnt vmcnt(0)" ::: "memory");
        } else {
            XB_SPIN(xb_ld(&bar[XB_XGEN(b.x)]) == gen, bar);
            __builtin_amdgcn_fence(__ATOMIC_ACQUIRE, "agent");
            asm volatile("s_waitcnt vmcnt(0)" ::: "memory");
        }
    }
    __syncthreads();
}

constexpr size_t WS_BAR = 512 * 1024;
constexpr int MISC_OFF = 131072 + 320;
__global__ void __launch_bounds__(512) fwd_megakernel(Params P) {
    extern __shared__ __attribute__((aligned(16))) unsigned char lds_raw[];
    LAS unsigned char* lds = (LAS unsigned char*)lds_raw;
    cg::grid_group grid = cg::this_grid();
    unsigned char* ws0 = P.ws;
    { unsigned* bw = (unsigned*)(ws0 + WS_BAR);
      if (bid() == 0) for (int i = threadIdx.x; i < XCD_BAR_WORDS; i += 512) __hip_atomic_store(bw + i, 0u, __ATOMIC_RELAXED, __HIP_MEMORY_SCOPE_AGENT);
      volatile LAS unsigned* misc = (volatile LAS unsigned*)(lds + MISC_OFF);
      if (threadIdx.x < 32) misc[threadIdx.x] = 0u; }
    if (EN(0)) prologue(P, lds);
    __threadfence();
    grid.sync();
    (void)xcd_barrier_post((unsigned*)(ws0 + WS_BAR), (volatile LAS unsigned*)(lds + MISC_OFF) + 8);
#define GBAR() do { XcdBarrier b_; b_.bar = (unsigned*)(P.ws + WS_BAR); b_.x = xb_xcc_id(); b_.st = (volatile LAS unsigned*)(lds + MISC_OFF) + 8; xcd_barrier(b_); } while (0)
#pragma unroll 1
    for (int l = 0; l < 4; ++l) {
        unsigned char* ws = P.ws; asm volatile("" : "+s"(ws));
#define X ((float*)(ws + WS_X))
#define XN ((bf16_t*)(ws + WS_XN))
#define BIG ((bf16_t*)(ws + WS_BIG))
#define ATT ((bf16_t*)(ws + WS_ATT))
#define MODV ((const float*)(ws + WS_MODV))
        const int M2 = (l == 3) ? ML : MT;
        if (EN(1)) norm_phase(P, l, 0, MT, l == 0);
        if (DB(3)) { GBAR(); norm_phase(P, l, 0, MT, l == 0); }
        GBAR(); asm volatile("" : "+s"(ws));
        if (!EN(2)) {} else if (l == 1) { run_gemm(lds, XN, (const bf16_t*)(ws + W_PW1), ML, 2048, 1024, pg8::EpiGlu{BIG, P.in[15]});
            small_gemm<2>(lds, XN + (size_t)ML * 1024, 1024, (const bf16_t*)(ws + W_PW1), 1024, 2048, 1, 0, FGlu{BIG + (size_t)ML * 1024, P.in[15]}); }
        else { const int Nq = (l == 2) ? 3072 : 1536, nk = (l == 2) ? 4 : 1; const bf16_t* Wq = (const bf16_t*)(ws + (l == 0 ? W_QKV0 : l == 2 ? W_QKV2 : W_QKV3));
               const float* gq = P.in[l == 0 ? 11 : l == 2 ? 23 : 32]; const float* gk = P.in[l == 0 ? 12 : l == 2 ? 24 : 33]; bf16_t* Vt = (bf16_t*)(ws + WS_VT);
               run_gemm(lds, XN, Wq, (l == 2) ? ML : MT, Nq, 1024, pg8::EpiQKV{BIG, Nq, nk, gq, gk, (const float*)(ws + WS_ROPE), Vt, MT, C2, EPS});
               if (l == 2) small_gemm<2>(lds, XN + (size_t)ML * 1024, 1024, Wq, 1024, Nq, 1, 0, FQkv{BIG + (size_t)ML * Nq, Nq, nk, gq, gk, Vt + ML, C2}); }
        GBAR(); asm volatile("" : "+s"(ws));
        if (l == 1) { if (EN(3)) conv_phase(P, lds, BIG, ATT); if (DB(5)) { GBAR(); conv_phase(P, lds, BIG, ATT); } }
        else {
            if (l == 0) { if (EN(5)) attn_gqa_phase<false>(P, lds, nullptr, P.in[11], P.in[12]); if (DB(0)) { GBAR(); attn_gqa_phase<false>(P, lds, nullptr, P.in[11], P.in[12]); } }
            else if (l == 2) { if (EN(6)) attn_diff_phase(P, lds); if (DB(1)) { GBAR(); attn_diff_phase(P, lds); } }
            else { if (EN(7)) attn_gqa_phase<true>(P, lds, P.in[34], P.in[32], P.in[33]); if (DB(5)) { GBAR(); attn_gqa_phase<true>(P, lds, P.in[34], P.in[32], P.in[33]); } }
        }
        GBAR(); asm volatile("" : "+s"(ws));
        { const bf16_t* Wo = (const bf16_t*)(ws + (l == 0 ? W_O0 : l == 1 ? W_PW2 : l == 2 ? W_O2 : W_O3)); const float* gate = MODV + (size_t)l * 3 * 6144 + 2048; const float* bo = l == 1 ? P.in[21] : nullptr;
          if (DB(6)) { run_gemm(lds, ATT, Wo, ML, 1024, 1024, pg8::EpiRes{X, P.out, gate, bo}); GBAR(); }
          if (EN(8)) { run_gemm(lds, ATT, Wo, ML, 1024, 1024, pg8::EpiRes{X, X, gate, bo});
              if (l < 3) small_gemm<1>(lds, ATT + (size_t)ML * 1024, 1024, Wo, 1024, 1024, 1, 0, FRes{X + (size_t)ML * 1024, gate + 2 * 6144, bo, 0}); } }
        GBAR(); asm volatile("" : "+s"(ws));
        if (EN(1)) norm_phase(P, l, 1, M2, 0);
        if (DB(3)) { GBAR(); norm_phase(P, l, 1, M2, 0); }
        GBAR(); asm volatile("" : "+s"(ws));
        { const bf16_t* Wu = (const bf16_t*)(ws + W_UP) + (size_t)l * 4096 * 1024;
          if (DB(2)) { run_gemm(lds, XN, Wu, ML, 4096, 1024, pg8::EpiSt<2>{BIG, 4096}); GBAR(); }
          if (EN(9)) { run_gemm(lds, XN, Wu, ML, 4096, 1024, pg8::EpiSt<2>{BIG, 4096});
              if (l < 3) small_gemm<1>(lds, XN + (size_t)ML * 1024, 1024, Wu, 1024, 4096, 1, 0, FSt{BIG + (size_t)ML * 4096, 4096, 2}); } }
        GBAR(); asm volatile("" : "+s"(ws));
        { const bf16_t* Wd = (const bf16_t*)(ws + W_DN) + (size_t)l * 4096 * 1024; const float* gate = MODV + (size_t)l * 3 * 6144 + 5120;
          if (DB(6)) { run_gemm(lds, BIG, Wd, ML, 1024, 4096, pg8::EpiRes{X, P.out, gate, nullptr}); GBAR(); }
          if (EN(10)) { run_gemm(lds, BIG, Wd, ML, 1024, 4096, pg8::EpiRes{X, l == 3 ? P.out : X, gate, nullptr});
              if (l < 3) small_gemm<1>(lds, BIG + (size_t)ML * 4096, 4096, Wd, 4096, 1024, 4, 0, FRes{X + (size_t)ML * 1024, gate + 2 * 6144, nullptr, 1}); } }
        if (l < 3) GBAR();
    }
}
#undef X
#undef XN
#undef BIG
#undef ATT
#undef MODV

extern "C" void kernel_launch(void* const* d_in, const int* in_sizes, int n_in, void* d_out, int out_size, void* d_ws, size_t ws_size, hipStream_t stream) {
    static int grid_blocks = 0;
    if (grid_blocks == 0) {
        if (n_in != 36 || out_size != ML * DM || ws_size < WS_END) { fprintf(stderr, "kernel_launch: unexpected problem (n_in %d, out %d, ws %zu)\n", n_in, out_size, ws_size); grid_blocks = -1; return; }
        int dev = 0, cus = 0, per_cu = 0;
        hipGetDevice(&dev); hipDeviceGetAttribute(&cus, hipDeviceAttributeMultiprocessorCount, dev);
        hipFuncSetAttribute((const void*)fwd_megakernel, hipFuncAttributeMaxDynamicSharedMemorySize, LDS_BYTES);
        if (hipOccupancyMaxActiveBlocksPerMultiprocessor(&per_cu, (const void*)fwd_megakernel, 512, LDS_BYTES) != hipSuccess || per_cu < 1) { fprintf(stderr, "kernel_launch: occupancy query gives %d\n", per_cu); per_cu = 1; }
        (void)hipGetLastError();
        grid_blocks = cus * 1;
        if (grid_blocks > 256) grid_blocks = 256;
        fprintf(stderr, "kernel_launch: cus %d per_cu %d grid %d\n", cus, per_cu, grid_blocks);
    }
    if (grid_blocks < 0) return;
    Params p{};
    for (int i = 0; i < 36; ++i) p.in[i] = (const float*)d_in[i];
    p.out = (float*)d_out; p.ws = (unsigned char*)d_ws;
    void* args[] = {&p};
    hipError_t e = hipLaunchCooperativeKernel((const void*)fwd_megakernel, dim3(grid_blocks), dim3(512), args, LDS_BYTES, stream);
    if (e != hipSuccess) fprintf(stderr, "cooperative launch failed: %s (grid %d)\n", hipGetErrorString(e), grid_blocks);
}
```

```cpp
#include <hip/hip_runtime.h>
#include <hip/hip_cooperative_groups.h>
#include <cstdio>
#include <cstdint>
namespace cg = cooperative_groups;
namespace pg8 {
#define PG8_LAS __attribute__((address_space(3)))
typedef unsigned short bf16_t;
typedef short bf16x8 __attribute__((ext_vector_type(8)));
typedef float f32x4 __attribute__((ext_vector_type(4)));
typedef unsigned u32x4 __attribute__((ext_vector_type(4)));
constexpr int BM = 256, BK = 64, HALF = 128, HTB = HALF * BK * 2  , STAGE_BYTES = 8 * HTB, NXCD = 8, WGM = 8;

__host__ __device__ __forceinline__ int lds_byte(int r, int c) { const int st = (r >> 4) * 2 + (c >> 5), rr = r & 15, cc = c & 31, ob = rr * 64 + cc * 2; return st * 1024 + (ob ^ (((ob >> 9) & 1) << 5)); }
__host__ __device__ __forceinline__ void stage_rc(int b, int& R, int& C) { const int st = b / 1024, sb = b % 1024, swz = sb ^ (((sb >> 9) & 1) << 5); R = (st >> 1) * 16 + swz / 64; C = (st & 1) * 32 + (swz % 64) / 2; }
__host__ __device__ __forceinline__ int perm32(int rho) { const int n = rho >> 4, i = rho & 15; return 8 * (i >> 2) + 4 * n + (i & 3); }

struct Unit { int pm, pn; };
struct Gemm { const bf16_t* A; const bf16_t* Bt; int M, N, K; };

struct StaticOrder {
    int nM, nN, nwg, G, c;
    __host__ __device__ void init(int M, int N, int G_, int c_) { nM = M / BM; nN = N / BM; nwg = nM * nN; G = G_; c = c_; }
    __host__ __device__ bool next(int i, Unit& u) const {
        const long L = (long)i * G + c; if (L >= nwg) return false;
        int wgid = (int)L; { const int q = nwg / NXCD, r = nwg % NXCD, xcd = wgid % NXCD, off = wgid / NXCD; wgid = (xcd < r ? xcd * (q + 1) : r * (q + 1) + (xcd - r) * q) + off; }
        const int nig = WGM * nN, gid = wgid / nig, fm = gid * WGM, gsz = (nM - fm) < WGM ? (nM - fm) : WGM;
        u.pm = fm + ((wgid % nig) % gsz); u.pn = (wgid % nig) / gsz; return true;
    }
    __device__ __forceinline__ void a_ready(const Unit&) const {}
    __device__ __forceinline__ void done(const Unit&) const {}
};

__device__ __forceinline__ unsigned cvt_pk_bf16(float lo, float hi) { unsigned r; asm volatile("v_cvt_pk_bf16_f32 %0, %1, %2" : "=v"(r) : "v"(lo), "v"(hi)); return r; }
typedef float f32x2 __attribute__((ext_vector_type(2)));
__device__ __forceinline__ f32x2 gelu_pk(f32x2 v) {
    const f32x2 av = __builtin_elementwise_abs(v), d = av * 0.2316418882f + 1.0f;
    f32x2 t; t.x = __builtin_amdgcn_rcpf(d.x); t.y = __builtin_amdgcn_rcpf(d.y);
    f32x2 q = t * 0.5307027145f + (-0.7265760135f); q = q * t + 0.7107068705f; q = q * t + (-0.142248368f); q = q * t + 0.127414796f; q = q * t;
    const f32x2 s = (v * v) * (-0.72134752044f);
    f32x2 e; e.x = __builtin_amdgcn_exp2f(s.x); e.y = __builtin_amdgcn_exp2f(s.y);
    const f32x2 m = v * (q * e), r = v - m;
    f32x2 o; o.x = v.x < 0.f ? m.x : r.x; o.y = v.y < 0.f ? m.y : r.y; return o;
}

template <int ACT  > struct EpiBf16 {
    static constexpr bool PERM = true, AFTER_DRAIN = false; static_assert(ACT == 0 || ACT == 1, "EpiBf16: ACT is 0 (none) or 1 (gelu_pk)");
    bf16_t* O; int ldc; const float* bias; int split_cols; size_t split_stride; float scale0;
    __device__ __forceinline__ void operator()(const f32x4 (&acc)[2][2][4][2], const Unit& u, int wr, int wc, int fr, int fq) const {
        const int row0 = u.pm * BM + wr * 64 + fr; int colt = u.pn * BM; bf16_t* base = O;
        float sc = 1.f; if (split_cols) { const int t = colt / split_cols; base += (size_t)t * split_stride; colt -= t * split_cols; if (t == 0) sc = scale0; }
        const int col0 = colt + wc * 32 + 8 * fq, bcol0 = u.pn * BM + wc * 32 + 8 * fq;
        f32x4 bv[2][2];
#pragma unroll
        for (int bj = 0; bj < 2; ++bj)
#pragma unroll
            for (int n = 0; n < 2; ++n) bv[bj][n] = bias ? *(const f32x4*)(bias + bcol0 + bj * HALF + 4 * n) : (f32x4){0.f, 0.f, 0.f, 0.f};
#pragma unroll
        for (int ai = 0; ai < 2; ++ai)
#pragma unroll
            for (int m = 0; m < 4; ++m) { bf16_t* rowp = base + (size_t)(row0 + ai * HALF + m * 16) * ldc + col0;
#pragma unroll
                for (int bj = 0; bj < 2; ++bj) { f32x4 v0 = acc[ai][bj][m][0] + bv[bj][0], v1 = acc[ai][bj][m][1] + bv[bj][1];
                    if (ACT == 1) { f32x2 a = gelu_pk((f32x2){v0[0], v0[1]}), b = gelu_pk((f32x2){v0[2], v0[3]}), c = gelu_pk((f32x2){v1[0], v1[1]}), d = gelu_pk((f32x2){v1[2], v1[3]});
                        v0 = (f32x4){a.x, a.y, b.x, b.y}; v1 = (f32x4){c.x, c.y, d.x, d.y}; }
                    v0 = v0 * sc; v1 = v1 * sc; u32x4 w; w.x = cvt_pk_bf16(v0[0], v0[1]); w.y = cvt_pk_bf16(v0[2], v0[3]); w.z = cvt_pk_bf16(v1[0], v1[1]); w.w = cvt_pk_bf16(v1[2], v1[3]);
                    *(u32x4*)(rowp + bj * HALF) = w; } }
    }
};

template <int ACT> struct EpiSt {
    static constexpr bool PERM = true, AFTER_DRAIN = false;
    bf16_t* O; int ldc;
    __device__ __forceinline__ void operator()(const f32x4 (&acc)[2][2][4][2], const Unit& u, int wr, int wc, int fr, int fq) const {
        const int row0 = u.pm * BM + wr * 64 + fr, col0 = u.pn * BM + wc * 32 + 8 * fq;
#pragma unroll
        for (int ai = 0; ai < 2; ++ai)
#pragma unroll
            for (int m = 0; m < 4; ++m) { bf16_t* rowp = O + (size_t)(row0 + ai * HALF + m * 16) * ldc + col0;
#pragma unroll
                for (int bj = 0; bj < 2; ++bj) { f32x4 v0 = acc[ai][bj][m][0], v1 = acc[ai][bj][m][1];
                    if (ACT == 2) {
#pragma unroll
                        for (int e = 0; e < 4; ++e) { const float a = v0[e] > 0.f ? v0[e] : 0.f, b = v1[e] > 0.f ? v1[e] : 0.f; v0[e] = a * a; v1[e] = b * b; } }
                    u32x4 w; w.x = cvt_pk_bf16(v0[0], v0[1]); w.y = cvt_pk_bf16(v0[2], v0[3]); w.z = cvt_pk_bf16(v1[0], v1[1]); w.w = cvt_pk_bf16(v1[2], v1[3]);
                    *(u32x4*)(rowp + bj * HALF) = w; } }
    }
};
struct EpiGlu {
    static constexpr bool PERM = true, AFTER_DRAIN = false;
    bf16_t* O; const float* bias;
    __device__ __forceinline__ void operator()(const f32x4 (&acc)[2][2][4][2], const Unit& u, int wr, int wc, int fr, int fq) const {
        const int row0 = u.pm * BM + wr * 64 + fr, ch0 = u.pn * HALF + wc * 32 + 8 * fq;
        f32x4 ba[2], bg[2];
#pragma unroll
        for (int n = 0; n < 2; ++n) { ba[n] = *(const f32x4*)(bias + ch0 + 4 * n); bg[n] = *(const f32x4*)(bias + 1024 + ch0 + 4 * n); }
#pragma unroll
        for (int ai = 0; ai < 2; ++ai)
#pragma unroll
            for (int m = 0; m < 4; ++m) { bf16_t* rowp = O + (size_t)(row0 + ai * HALF + m * 16) * 1024 + ch0;
                f32x4 r[2];
#pragma unroll
                for (int n = 0; n < 2; ++n) { const f32x4 a = acc[ai][0][m][n] + ba[n], g = acc[ai][1][m][n] + bg[n];
#pragma unroll
                    for (int e = 0; e < 4; ++e) r[n][e] = a[e] / (1.0f + __expf(-g[e])); }
                u32x4 w; w.x = cvt_pk_bf16(r[0][0], r[0][1]); w.y = cvt_pk_bf16(r[0][2], r[0][3]); w.z = cvt_pk_bf16(r[1][0], r[1][1]); w.w = cvt_pk_bf16(r[1][2], r[1][3]);
                *(u32x4*)(rowp) = w; }
    }
};
struct EpiRes {
    static constexpr bool PERM = false, AFTER_DRAIN = false;
    const float* Xin; float* Xout; const float* gate; const float* bias;
    __device__ __forceinline__ void operator()(const f32x4 (&acc)[2][2][4][2], const Unit& u, int wr, int wc, int fr, int fq) const {
        const int r0 = u.pm * BM; const int rt = r0 < 8192 ? 0 : (r0 < 16384 ? 1 : 2);
        const float* gp = gate + rt * 6144;
        const int col0 = u.pn * BM + wc * 32 + 4 * fq;
        f32x4 gv[2][2], bv[2][2];
#pragma unroll
        for (int bj = 0; bj < 2; ++bj)
#pragma unroll
            for (int n = 0; n < 2; ++n) { const int c = col0 + bj * HALF + n * 16; gv[bj][n] = *(const f32x4*)(gp + c); bv[bj][n] = bias ? *(const f32x4*)(bias + c) : (f32x4){0.f, 0.f, 0.f, 0.f}; }
#pragma unroll
        for (int ai = 0; ai < 2; ++ai)
#pragma unroll
            for (int m = 0; m < 4; ++m) { const size_t off = (size_t)(r0 + ai * HALF + wr * 64 + m * 16 + fr) * 1024 + col0;
#pragma unroll
                for (int bj = 0; bj < 2; ++bj)
#pragma unroll
                    for (int n = 0; n < 2; ++n) { const size_t p = off + bj * HALF + n * 16; f32x4 x = *(const f32x4*)(Xin + p); x = x + gv[bj][n] * (acc[ai][bj][m][n] + bv[bj][n]); *(f32x4*)(Xout + p) = x; }
                if (m & 1) asm volatile("" ::: "memory"); }
    }
};

struct EpiQKV {
    static constexpr bool PERM = false, AFTER_DRAIN = false;
    bf16_t* O; int pitch; int nk; const float* gq; const float* gk; const float* rope; bf16_t* Vt; int vpitch; float qscale; float eps;
    __device__ __forceinline__ void operator()(const f32x4 (&acc)[2][2][4][2], const Unit& u, int wr, int wc, int fr, int fq) const {
        const int r0 = u.pm * BM + wr * 64 + fr; const bool lat = u.pm * BM < 16384;
        if (u.pn < 4 + nk) {
            const bool isq = u.pn < 4; const float* g = isq ? gq : gk; const float sc = isq ? qscale : 1.0f;
            f32x4 g4[2][2];
#pragma unroll
            for (int bj = 0; bj < 2; ++bj)
#pragma unroll
                for (int n = 0; n < 2; ++n) g4[bj][n] = *(const f32x4*)(g + 32 * bj + 16 * n + 4 * fq);
#pragma unroll
            for (int ai = 0; ai < 2; ++ai)
#pragma unroll
                for (int m = 0; m < 4; ++m) { const int row = r0 + ai * HALF + m * 16; const int t = row & 8191;
                    float ss = 0.f;
#pragma unroll
                    for (int bj = 0; bj < 2; ++bj)
#pragma unroll
                        for (int n = 0; n < 2; ++n) { const f32x4 v = acc[ai][bj][m][n]; ss += (v[0] * v[0] + v[1] * v[1]) + (v[2] * v[2] + v[3] * v[3]); }
                    ss += __shfl_xor(ss, 16); ss += __shfl_xor(ss, 32);
                    const float rs = sc / sqrtf(ss * (1.0f / 64.0f) + eps);
                    bf16_t* op = O + (size_t)row * pitch + u.pn * BM + wc * 64 + 4 * fq;
#pragma unroll
                    for (int bj = 0; bj < 2; ++bj)
#pragma unroll
                        for (int n = 0; n < 2; ++n) { const f32x4 cs = lat ? *(const f32x4*)(rope + (size_t)t * 64 + 32 * bj + 16 * n + 4 * fq) : (f32x4){1.f, 0.f, 1.f, 0.f};
                            const f32x4 y = acc[ai][bj][m][n] * g4[bj][n] * rs;
                            const float o0 = y[0] * cs[0] - y[1] * cs[1], o1 = y[0] * cs[1] + y[1] * cs[0], o2 = y[2] * cs[2] - y[3] * cs[3], o3 = y[2] * cs[3] + y[3] * cs[2];
                            unsigned w0 = cvt_pk_bf16(o0, o1), w1 = cvt_pk_bf16(o2, o3);
                            typedef unsigned u32x2_ __attribute__((ext_vector_type(2)));
                            *(u32x2_*)(op + 32 * bj + 16 * n) = (u32x2_){w0, w1}; }
                    if (m & 1) asm volatile("" ::: "memory"); }
        } else {
            const int vc0 = (u.pn - 4 - nk) * BM + wc * 64 + 4 * fq;
#pragma unroll
            for (int ai = 0; ai < 2; ++ai)
#pragma unroll
                for (int m = 0; m < 4; ++m) { const int row = r0 + ai * HALF + m * 16;
#pragma unroll
                    for (int bj = 0; bj < 2; ++bj)
#pragma unroll
                        for (int n = 0; n < 2; ++n) { const f32x4 v = acc[ai][bj][m][n]; const unsigned w0 = cvt_pk_bf16(v[0], v[1]), w1 = cvt_pk_bf16(v[2], v[3]);
                            bf16_t* vp = Vt + (size_t)(vc0 + 32 * bj + 16 * n) * vpitch + row;
                            vp[0] = (bf16_t)(w0 & 0xffffu); vp[vpitch] = (bf16_t)(w0 >> 16); vp[2 * (size_t)vpitch] = (bf16_t)(w1 & 0xffffu); vp[3 * (size_t)vpitch] = (bf16_t)(w1 >> 16); } }
        }
    }
};

template <class Epi, class Sched, bool ALIGN_EPI = false, bool SP2 = false>
__device__ __forceinline__ void gemm_phase(PG8_LAS unsigned char* lds, const Gemm g, const Sched& S, const Epi& E) {
    int tid_o = threadIdx.x; asm volatile("" : "+v"(tid_o)); const int tid = tid_o, wid = __builtin_amdgcn_readfirstlane(tid >> 6), lane = tid & 63, wr = wid >> 2, wc = wid & 3, fr = lane & 15, fq = lane >> 4;
    const int K = g.K, nt = K / BK;
    unsigned voffA[2], voffB[2];
#pragma unroll
    for (int i = 0; i < 2; ++i) { int R, C; stage_rc(tid * 16 + i * 8192, R, C); const int Rb = Epi::PERM ? ((R & ~31) + perm32(R & 31)) : R;
        voffA[i] = (unsigned)(R * K + C) * 2u; voffB[i] = (unsigned)(Rb * K + C) * 2u; }
    const size_t kstep = (size_t)(BK * 2);
    const size_t hstep = (size_t)HALF * K * 2;
    const size_t tstep = 2 * hstep;
    const unsigned ldsw = (unsigned)wid * 1024u;
    const int aoff = lds_byte(wr * 64 + fr, fq * 8), boff = lds_byte(wc * 32 + fr, fq * 8);
#define PG8_SA(b, h) (((b) * 2 + (h)) * HTB)
#define PG8_SB(b, h) ((4 + (b) * 2 + (h)) * HTB)
#define PG8_STAGE(bufoff, gbase, voff) do { _Pragma("unroll") for (int _i = 0; _i < 2; ++_i) \
        __builtin_amdgcn_global_load_lds((const unsigned*)((const char*)(gbase) + (voff)[_i]), (PG8_LAS unsigned*)(lds + (bufoff) + ldsw + _i * 8192), 16, 0, 0); } while (0)
#define PG8_LDA(dst, b, h) do { _Pragma("unroll") for (int m = 0; m < 4; ++m) _Pragma("unroll") for (int k = 0; k < 2; ++k) dst[m][k] = *(const PG8_LAS bf16x8*)(lds + PG8_SA(b, h) + aoff + m * 2048 + k * 1024); } while (0)
#define PG8_LDB(dst, b, h) do { _Pragma("unroll") for (int n = 0; n < 2; ++n) _Pragma("unroll") for (int k = 0; k < 2; ++k) dst[n][k] = *(const PG8_LAS bf16x8*)(lds + PG8_SB(b, h) + boff + n * 2048 + k * 1024); } while (0)
#define PG8_MMA(ai, bj, At, Bt) do { __builtin_amdgcn_s_setprio(1); _Pragma("unroll") for (int m = 0; m < 4; ++m) _Pragma("unroll") for (int n = 0; n < 2; ++n) _Pragma("unroll") for (int k = 0; k < 2; ++k) \
        acc[ai][bj][m][n] = __builtin_amdgcn_mfma_f32_16x16x32_bf16(Bt[n][k], At[m][k], acc[ai][bj][m][n], 0, 0, 0); __builtin_amdgcn_s_setprio(0); } while (0)
#define PG8_WAIT_V(n) asm volatile("s_waitcnt vmcnt(" #n ")" ::: "memory")
#define PG8_WAIT_L(n) asm volatile("s_waitcnt lgkmcnt(" #n ")" ::: "memory")
#define PG8_BAR __builtin_amdgcn_s_barrier()
#define PG8_SCHED __builtin_amdgcn_sched_barrier(0)
    Unit cur, nxt; int ui = 0;
    if (!S.next(0, cur)) return;
    f32x4 acc[2][2][4][2];
#pragma unroll
    for (int a = 0; a < 2; ++a)
#pragma unroll
        for (int b = 0; b < 2; ++b)
#pragma unroll
            for (int m = 0; m < 4; ++m)
#pragma unroll
                for (int n = 0; n < 2; ++n) acc[a][b][m][n] = (f32x4){0.f, 0.f, 0.f, 0.f};
    bf16x8 At[4][2], B0[2][2], B1[2][2];
    const char* cA = (const char*)g.A + (size_t)cur.pm * tstep; const char* cB = (const char*)g.Bt + (size_t)cur.pn * tstep;
    S.a_ready(cur);
    if constexpr (SP2) {
        PG8_STAGE(PG8_SB(0, 0), cB, voffB); PG8_STAGE(PG8_SB(0, 1), cB + hstep, voffB); PG8_STAGE(PG8_SA(0, 0), cA, voffA); PG8_STAGE(PG8_SA(0, 1), cA + hstep, voffA);
        if (wr == 1) PG8_BAR;
        PG8_WAIT_V(2); PG8_BAR;
        PG8_STAGE(PG8_SB(1, 0), cB + kstep, voffB); PG8_STAGE(PG8_SA(1, 0), cA + kstep, voffA); PG8_STAGE(PG8_SB(1, 1), cB + hstep + kstep, voffB);
        PG8_WAIT_V(6); PG8_BAR;
    } else {
        PG8_STAGE(PG8_SB(0, 0), cB, voffB); PG8_STAGE(PG8_SA(0, 0), cA, voffA); PG8_STAGE(PG8_SB(0, 1), cB + hstep, voffB); PG8_STAGE(PG8_SA(0, 1), cA + hstep, voffA);
        if (wr == 1) PG8_BAR;
        PG8_WAIT_V(4); PG8_BAR;
        PG8_STAGE(PG8_SB(1, 0), cB + kstep, voffB); PG8_STAGE(PG8_SA(1, 0), cA + kstep, voffA); PG8_STAGE(PG8_SB(1, 1), cB + hstep + kstep, voffB);
        PG8_WAIT_V(6); PG8_BAR;
    }
    for (;;) {
        const bool has_next = S.next(ui + 1, nxt);
        const char* nA = has_next ? (const char*)g.A + (size_t)nxt.pm * tstep : cA; const char* nB = has_next ? (const char*)g.Bt + (size_t)nxt.pn * tstep : cB;
        for (int t = 0; t < nt; t += 2) {
            const bool last = (t == nt - 2);
            const char* a1 = cA + (size_t)(t + 1) * kstep;
            const char* a2 = last ? nA : cA + (size_t)(t + 2) * kstep; const char* b2 = last ? nB : cB + (size_t)(t + 2) * kstep;
            const char* a3 = a2 + kstep; const char* b3 = b2 + kstep;
            if (last && has_next) S.a_ready(nxt);
            if constexpr (SP2) {
            PG8_LDB(B0, 0, 0); PG8_LDB(B1, 0, 1); PG8_SCHED; PG8_LDA(At, 0, 0); PG8_STAGE(PG8_SA(1, 1), a1 + hstep, voffA);
            PG8_WAIT_V(8); PG8_WAIT_L(0); PG8_BAR; PG8_MMA(0, 0, At, B0); PG8_MMA(0, 1, At, B1); PG8_BAR; PG8_SCHED;
            PG8_LDA(At, 0, 1); PG8_STAGE(PG8_SB(0, 0), b2, voffB); PG8_STAGE(PG8_SB(0, 1), b2 + hstep, voffB); PG8_STAGE(PG8_SA(0, 0), a2, voffA);
            PG8_WAIT_V(8); PG8_WAIT_L(0); PG8_BAR; PG8_MMA(1, 0, At, B0); PG8_MMA(1, 1, At, B1); PG8_BAR; PG8_SCHED;
            PG8_LDB(B0, 1, 0); PG8_LDB(B1, 1, 1); PG8_SCHED; PG8_LDA(At, 1, 0); PG8_STAGE(PG8_SA(0, 1), a2 + hstep, voffA);
            PG8_WAIT_V(8); PG8_WAIT_L(0); PG8_BAR; PG8_MMA(0, 0, At, B0); PG8_MMA(0, 1, At, B1); PG8_BAR; PG8_SCHED;
            PG8_LDA(At, 1, 1); PG8_STAGE(PG8_SB(1, 0), b3, voffB); PG8_STAGE(PG8_SB(1, 1), b3 + hstep, voffB); PG8_STAGE(PG8_SA(1, 0), a3, voffA);
            PG8_WAIT_V(8); PG8_WAIT_L(0); PG8_BAR; PG8_MMA(1, 0, At, B0); PG8_MMA(1, 1, At, B1); PG8_BAR; PG8_SCHED;
            } else {
            PG8_LDB(B0, 0, 0); PG8_SCHED; PG8_LDA(At, 0, 0); PG8_STAGE(PG8_SA(1, 1), a1 + hstep, voffA);
            PG8_WAIT_L(8); PG8_BAR; PG8_WAIT_L(0); PG8_MMA(0, 0, At, B0); PG8_BAR; PG8_SCHED;
            PG8_LDB(B1, 0, 1); PG8_STAGE(PG8_SB(0, 0), b2, voffB);
            PG8_BAR; PG8_WAIT_L(0); PG8_MMA(0, 1, At, B1); PG8_BAR;
            PG8_LDA(At, 0, 1); PG8_STAGE(PG8_SA(0, 0), a2, voffA);
            PG8_BAR; PG8_WAIT_L(0); PG8_MMA(1, 0, At, B0); PG8_BAR; PG8_SCHED;
            PG8_STAGE(PG8_SB(0, 1), b2 + hstep, voffB);
            PG8_WAIT_V(6); PG8_BAR; PG8_MMA(1, 1, At, B1); PG8_BAR;
            PG8_LDB(B0, 1, 0); PG8_SCHED; PG8_LDA(At, 1, 0); PG8_STAGE(PG8_SA(0, 1), a2 + hstep, voffA);
            PG8_WAIT_L(8); PG8_BAR; PG8_WAIT_L(0); PG8_MMA(0, 0, At, B0); PG8_BAR; PG8_SCHED;
            PG8_LDB(B1, 1, 1); PG8_STAGE(PG8_SB(1, 0), b3, voffB);
            PG8_BAR; PG8_WAIT_L(0); PG8_MMA(0, 1, At, B1); PG8_BAR;
            PG8_LDA(At, 1, 1); PG8_STAGE(PG8_SA(1, 0), a3, voffA);
            PG8_BAR; PG8_WAIT_L(0); PG8_MMA(1, 0, At, B0); PG8_BAR; PG8_SCHED;
            PG8_STAGE(PG8_SB(1, 1), b3 + hstep, voffB);
            PG8_WAIT_V(6); PG8_BAR; PG8_MMA(1, 1, At, B1); PG8_BAR;
            }
        }
        if constexpr (ALIGN_EPI) { if (wr == 0) PG8_BAR; }
        if constexpr (!Epi::AFTER_DRAIN) { E(acc, cur, wr, wc, fr, fq); S.done(cur); }
        if (!has_next) break;
#pragma unroll
        for (int a = 0; a < 2; ++a)
#pragma unroll
            for (int b = 0; b < 2; ++b)
#pragma unroll
                for (int m = 0; m < 4; ++m)
#pragma unroll
                    for (int n = 0; n < 2; ++n) acc[a][b][m][n] = (f32x4){0.f, 0.f, 0.f, 0.f};
        cur = nxt; cA = nA; cB = nB; ++ui;
        if constexpr (ALIGN_EPI) { if (wr == 1) PG8_BAR; }
    }
    PG8_WAIT_V(0);
    if constexpr (!ALIGN_EPI) { if (wr == 0) PG8_BAR; }
    PG8_BAR;
    if constexpr (Epi::AFTER_DRAIN) { E.fused(acc, cur, wr, wc, fr, fq, lds, wid, lane); S.done(cur); }
#undef PG8_SA
#undef PG8_SB
#undef PG8_STAGE
#undef PG8_LDA
#undef PG8_LDB
#undef PG8_MMA
#undef PG8_WAIT_V
#undef PG8_WAIT_L
#undef PG8_BAR
#undef PG8_SCHED
}
}


#define LAS __attribute__((address_space(3)))
#define DI __device__ __forceinline__
__device__ __forceinline__ int bid() { int b = blockIdx.x; asm volatile("" : "+s"(b)); return b; }
typedef unsigned short bf16_t;
typedef short bf16x8 __attribute__((ext_vector_type(8)));
typedef float f32x4 __attribute__((ext_vector_type(4)));
typedef float f32x2 __attribute__((ext_vector_type(2)));
typedef float f32x16 __attribute__((ext_vector_type(16)));
typedef unsigned u32x4 __attribute__((ext_vector_type(4)));
typedef unsigned u32x2 __attribute__((ext_vector_type(2)));
typedef __bf16 bf16x2_t __attribute__((ext_vector_type(2)));

constexpr int BATCH = 2, SEQ = 8192, DM = 1024, CTXL = 256, FF = 4096;
constexpr int ML = BATCH * SEQ;
constexpr int MT = ML + BATCH * CTXL;
constexpr float EPS = 1e-6f;
constexpr float C2 = 0.125f * 1.4426950408889634f;
constexpr float LOG2E = 1.4426950408889634f;

constexpr size_t MiB = (size_t)1 << 20;
constexpr size_t WS_MODV = 0;
constexpr size_t WS_ROPE = 1 * MiB;
constexpr size_t WS_W = 3 * MiB;
constexpr size_t W_QKV0 = WS_W, W_O0 = WS_W + 3 * MiB, W_PW1 = WS_W + 5 * MiB, W_PW2 = WS_W + 9 * MiB, W_QKV2 = WS_W + 11 * MiB, W_O2 = WS_W + 17 * MiB,
                 W_QKV3 = WS_W + 19 * MiB, W_O3 = WS_W + 22 * MiB, W_UP = WS_W + 24 * MiB, W_DN = WS_W + 56 * MiB;
constexpr size_t WS_X = 91 * MiB;
constexpr size_t WS_XN = 157 * MiB;
constexpr size_t WS_BIG = 190 * MiB;
constexpr size_t WS_ATT = WS_BIG + 99 * MiB;
constexpr size_t WS_VT = 322 * MiB;
constexpr size_t WS_END = 355 * MiB;
constexpr int LDS_BYTES = 147456;

struct Params { const float* in[36]; float* out; unsigned char* ws; };

DI unsigned pk2(float lo, float hi) { f32x2 v = {lo, hi}; bf16x2_t b = __builtin_convertvector(v, bf16x2_t); return __builtin_bit_cast(unsigned, b); }
DI float bflo(unsigned w) { return __uint_as_float(w << 16); }
DI float bfhi(unsigned w) { return __uint_as_float(w & 0xffff0000u); }
DI float wave_sum(float v) {
#pragma unroll
    for (int o = 1; o < 64; o <<= 1) v += __shfl_xor(v, o);
    return v;
}
DI float half_swap_max(float v) { auto rr = __builtin_amdgcn_permlane32_swap(__float_as_uint(v), __float_as_uint(v), false, false); return fmaxf(__uint_as_float(rr[0]), __uint_as_float(rr[1])); }
DI float half_swap_sum(float v) { auto rr = __builtin_amdgcn_permlane32_swap(__float_as_uint(v), __float_as_uint(v), false, false); return __uint_as_float(rr[0]) + __uint_as_float(rr[1]); }

DI void transpose_item(const float* W, int K, int N, bf16_t* WT, int dst_row0, LAS float* scr, int k0, int n0, int lane) {
#pragma unroll
    for (int i = 0; i < 32; ++i) { const int kk = 2 * i + (lane >> 5); scr[kk * 33 + (lane & 31)] = W[(size_t)(k0 + kk) * N + n0 + (lane & 31)]; }
    asm volatile("s_waitcnt lgkmcnt(0)" ::: "memory");
    const int c = lane & 7;
#pragma unroll
    for (int j = 0; j < 4; ++j) { const int n = (lane >> 3) + 8 * j; const LAS float* s = scr + (8 * c) * 33 + n;
        u32x4 o; o.x = pk2(s[0 * 33], s[1 * 33]); o.y = pk2(s[2 * 33], s[3 * 33]); o.z = pk2(s[4 * 33], s[5 * 33]); o.w = pk2(s[6 * 33], s[7 * 33]);
        *(u32x4*)(WT + (size_t)(dst_row0 + n) * K + k0 + 8 * c) = o; }
    asm volatile("s_waitcnt lgkmcnt(0)" ::: "memory");
}

DI void prologue(const Params& P, LAS unsigned char* lds) {
    int tid_o = threadIdx.x; asm volatile("" : "+v"(tid_o)); const int tid = tid_o, lane = tid & 63, wid = tid >> 6;
    unsigned char* ws = P.ws;
    float* MODV = (float*)(ws + WS_MODV);
    {
        LAS float* sv = (LAS float*)lds; LAS float* red = sv + 3072;
        for (int i = tid; i < 3072; i += 512) { const int v = i >> 10, k = i & 1023; const float c = v < 2 ? P.in[1][v * 1024 + k] : P.in[3][k]; sv[i] = c / (1.0f + __expf(-c)); }
        __syncthreads();
        for (int item = bid(); item < 384; item += gridDim.x) {
            const int l = item / 96, cc = item % 96; const int col = cc * 64 + lane;
            const float* W = P.in[6] + (size_t)l * 1024 * 6144 + col;
            float a0 = 0.f, a1 = 0.f, a2 = 0.f;
#pragma unroll 32
            for (int kk = 0; kk < 128; ++kk) { const int k = wid * 128 + kk; const float w = W[(size_t)k * 6144]; a0 += sv[k] * w; a1 += sv[1024 + k] * w; a2 += sv[2048 + k] * w; }
            red[(wid * 3 + 0) * 64 + lane] = a0; red[(wid * 3 + 1) * 64 + lane] = a1; red[(wid * 3 + 2) * 64 + lane] = a2;
            __syncthreads();
            if (tid < 192) { const int v = tid >> 6; float s = 0.f;
#pragma unroll
                for (int w = 0; w < 8; ++w) s += red[(w * 3 + v) * 64 + lane];
                MODV[(size_t)(l * 3 + v) * 6144 + col] = s + P.in[7][l * 6144 + col]; }
            __syncthreads();
        }
    }
    if (bid() == 0 && tid == 0) {
        float s1 = 0.f, s2 = 0.f;
        for (int i = 0; i < 64; ++i) { s1 += P.in[25][i] * P.in[26][i]; s2 += P.in[27][i] * P.in[28][i]; }
        const float lam_init = 0.8f - 0.6f * 0.5488116360940264f;
        MODV[73728] = __expf(s1) - __expf(s2) + lam_init;
    }
    const int gw = bid() * 8 + wid, NGW = gridDim.x * 8;
    {
        f32x2* R = (f32x2*)(ws + WS_ROPE);
        for (int e = gw * 64 + lane; e < 8192 * 32; e += NGW * 64) { const int t = e >> 5, i = e & 31; const int j = i & 15; const float pos = (float)(i < 16 ? (t >> 6) : (t & 63));
            const float inv = 1.0f / exp2f((float)j * 0.83048202372184f); const float ang = pos * inv; R[e] = (f32x2){__cosf(ang), __sinf(ang)}; }
    }
    {
        LAS float* scr = (LAS float*)(lds + 32768 + wid * 8704);
        constexpr int NIT = 22528;
        for (int it = gw; it < NIT; it += NGW) {
            int r = it; const float* W; int K, N; bf16_t* WT; int mode = 0;
            if (r < 768) { W = P.in[10]; K = 1024; N = 1536; WT = (bf16_t*)(ws + W_QKV0); mode = 2; }
            else if ((r -= 768) < 512) { W = P.in[13]; K = 1024; N = 1024; WT = (bf16_t*)(ws + W_O0); }
            else if ((r -= 512) < 1024) { W = P.in[14]; K = 1024; N = 2048; WT = (bf16_t*)(ws + W_PW1); mode = 1; }
            else if ((r -= 1024) < 512) { W = P.in[20]; K = 1024; N = 1024; WT = (bf16_t*)(ws + W_PW2); }
            else if ((r -= 512) < 1536) { W = P.in[22]; K = 1024; N = 3072; WT = (bf16_t*)(ws + W_QKV2); mode = 2; }
            else if ((r -= 1536) < 512) { W = P.in[30]; K = 1024; N = 1024; WT = (bf16_t*)(ws + W_O2); }
            else if ((r -= 512) < 768) { W = P.in[31]; K = 1024; N = 1536; WT = (bf16_t*)(ws + W_QKV3); mode = 2; }
            else if ((r -= 768) < 512) { W = P.in[35]; K = 1024; N = 1024; WT = (bf16_t*)(ws + W_O3); }
            else if ((r -= 512) < 8192) { const int l = r >> 11; r &= 2047; W = P.in[8] + (size_t)l * 1024 * 4096; K = 1024; N = 4096; WT = (bf16_t*)(ws + W_UP) + (size_t)l * 4096 * 1024; }
            else { r -= 8192; const int l = r >> 11; r &= 2047; W = P.in[9] + (size_t)l * 4096 * 1024; K = 4096; N = 1024; WT = (bf16_t*)(ws + W_DN) + (size_t)l * 4096 * 1024; }
            const int nblk = N / 32, kb = r / nblk, nb = r % nblk, k0 = 64 * kb, n0 = 32 * nb;
            int dst = n0;
            if (mode == 1) { const int bj = n0 >> 10, j = n0 & 1023; dst = 256 * (j >> 7) + 128 * bj + (j & 127); }
            if (mode == 2) { const int c = n0 & 255; dst = (n0 & ~255) + 128 * ((c & 63) >> 5) + 32 * (c >> 6) + (c & 31); }
            transpose_item(W, K, N, WT, dst, scr, k0, n0, lane);
        }
    }
}

DI void norm_phase(const Params& P, int l, int which  , int M, int first) {
    int tid_o = threadIdx.x; asm volatile("" : "+v"(tid_o)); const int tid = tid_o, lane = tid & 63, wid = tid >> 6;
    const int gw = bid() * 8 + wid, NGW = gridDim.x * 8;
    float* X = (float*)(P.ws + WS_X); bf16_t* XN = (bf16_t*)(P.ws + WS_XN);
    const float* MODV = (const float*)(P.ws + WS_MODV);
    const float* g = P.in[which ? 5 : 4] + l * 1024;
    f32x4 gv[4];
#pragma unroll
    for (int j = 0; j < 4; ++j) gv[j] = *(const f32x4*)(g + 4 * lane + 256 * j);
    for (int rowa = gw; rowa < M; rowa += 2 * NGW) {
        f32x4 v[2][4]; float s[2]; int rows[2]; bool ok[2];
#pragma unroll
        for (int q = 0; q < 2; ++q) { const int row = rowa + q * NGW; rows[q] = row; ok[q] = row < M; s[q] = 0.f;
            const int rr = ok[q] ? row : rowa;
            const float* src = first ? (rr < ML ? P.in[0] + (size_t)rr * 1024 : P.in[2] + (size_t)(rr - ML) * 1024) : X + (size_t)rr * 1024;
#pragma unroll
            for (int j = 0; j < 4; ++j) v[q][j] = *(const f32x4*)(src + 4 * lane + 256 * j); }
#pragma unroll
        for (int q = 0; q < 2; ++q) {
#pragma unroll
            for (int j = 0; j < 4; ++j) s[q] += (v[q][j].x * v[q][j].x + v[q][j].y * v[q][j].y) + (v[q][j].z * v[q][j].z + v[q][j].w * v[q][j].w);
            s[q] = wave_sum(s[q]); }
#pragma unroll
        for (int q = 0; q < 2; ++q) if (ok[q]) { const int row = rows[q];
            const int rt = row < 8192 ? 0 : (row < 16384 ? 1 : 2);
            const float* mv = MODV + (size_t)(l * 3 + rt) * 6144 + which * 3072;
            if (first) {
#pragma unroll
                for (int j = 0; j < 4; ++j) *(f32x4*)(X + (size_t)row * 1024 + 4 * lane + 256 * j) = v[q][j];
            }
            const float rs = 1.0f / sqrtf(s[q] * (1.0f / 1024.0f) + EPS);
#pragma unroll
            for (int j = 0; j < 4; ++j) { const int c = 4 * lane + 256 * j; const f32x4 sh = *(const f32x4*)(mv + c), sc = *(const f32x4*)(mv + 1024 + c);
                const f32x4 y = (v[q][j] * rs) * gv[j] * (sc + 1.0f) + sh;
                u32x2 w; w.x = pk2(y.x, y.y); w.y = pk2(y.z, y.w); *(u32x2*)(XN + (size_t)row * 1024 + c) = w; } }
    }
}

DI void qk_post(const Params& P, bf16_t* QKV, int pitch, int NV, const float* gq, const float* gk) {
    int tid_o = threadIdx.x; asm volatile("" : "+v"(tid_o)); const int tid = tid_o, lane = tid & 63, wid = tid >> 6, sub = lane & 7, vl = lane >> 3;
    const int gw = bid() * 8 + wid, NGW = gridDim.x * 8;
    const f32x2* R = (const f32x2*)(P.ws + WS_ROPE);
    float gqv[8], gkv[8];
#pragma unroll
    for (int e = 0; e < 8; ++e) { gqv[e] = gq[sub * 8 + e]; gkv[e] = gk[sub * 8 + e]; }
    const int nit = (NV + 7) >> 3;
    for (int row = gw; row < MT; row += NGW) {
        bf16_t* rp = QKV + (size_t)row * pitch;
        const bool lat = row < ML; const int t = row & 8191;
        f32x2 cs[4];
        if (lat) {
#pragma unroll
            for (int pr = 0; pr < 4; ++pr) cs[pr] = R[t * 32 + sub * 4 + pr];
        } else {
#pragma unroll
            for (int pr = 0; pr < 4; ++pr) cs[pr] = (f32x2){1.0f, 0.0f};
        }
        for (int it = 0; it < nit; ++it) {
            const int vec = it * 8 + vl; const bool act = vec < NV;
            u32x4 raw = (u32x4){0u, 0u, 0u, 0u};
            if (act) raw = *(const u32x4*)(rp + vec * 64 + sub * 8);
            float x[8] = {bflo(raw.x), bfhi(raw.x), bflo(raw.y), bfhi(raw.y), bflo(raw.z), bfhi(raw.z), bflo(raw.w), bfhi(raw.w)};
            float ss = 0.f;
#pragma unroll
            for (int e = 0; e < 8; ++e) ss += x[e] * x[e];
            ss += __shfl_xor(ss, 1); ss += __shfl_xor(ss, 2); ss += __shfl_xor(ss, 4);
            const float rs = 1.0f / sqrtf(ss * (1.0f / 64.0f) + EPS);
            const bool isq = vec < 16; const float qs = isq ? C2 : 1.0f;
            float y[8];
#pragma unroll
            for (int e = 0; e < 8; ++e) y[e] = x[e] * rs * (isq ? gqv[e] : gkv[e]);
#pragma unroll
            for (int pr = 0; pr < 4; ++pr) { const float a = y[2 * pr], b = y[2 * pr + 1]; y[2 * pr] = (a * cs[pr].x - b * cs[pr].y) * qs; y[2 * pr + 1] = (a * cs[pr].y + b * cs[pr].x) * qs; }
            if (act) { u32x4 o; o.x = pk2(y[0], y[1]); o.y = pk2(y[2], y[3]); o.z = pk2(y[4], y[5]); o.w = pk2(y[6], y[7]); *(u32x4*)(rp + vec * 64 + sub * 8) = o; }
        }
    }
}
DI void v_transpose(const Params& P, LAS unsigned char* lds, const bf16_t* QKV, int pitch, int vcol0, int nvc) {
    int tid_o = threadIdx.x; asm volatile("" : "+v"(tid_o)); const int tid = tid_o, lane = tid & 63, wid = tid >> 6;
    const int gw = bid() * 8 + wid, NGW = gridDim.x * 8;
    bf16_t* Vt = (bf16_t*)(P.ws + WS_VT);
    LAS unsigned char* scr = lds + wid * 9216;
    const int ncb = nvc >> 6, nitems = (MT / 64) * ncb;
    for (int it = gw; it < nitems; it += NGW) {
        const int tb = it / ncb, cb = it % ncb; const int row0 = tb * 64, c0 = vcol0 + cb * 64;
#pragma unroll
        for (int i = 0; i < 8; ++i) { const int rr = i * 8 + (lane >> 3), ch = lane & 7; const u32x4 v = *(const u32x4*)(QKV + (size_t)(row0 + rr) * pitch + c0 + ch * 8); *(LAS u32x4*)(scr + rr * 144 + ch * 16) = v; }
        asm volatile("s_waitcnt lgkmcnt(0)" ::: "memory");
#pragma unroll
        for (int i = 0; i < 8; ++i) { const int c = i * 8 + (lane >> 3), t8 = (lane & 7) * 8;
            unsigned short h[8];
#pragma unroll
            for (int e = 0; e < 8; ++e) h[e] = *(const LAS unsigned short*)(scr + (t8 + e) * 144 + c * 2);
            u32x4 o; o.x = (unsigned)h[0] | ((unsigned)h[1] << 16); o.y = (unsigned)h[2] | ((unsigned)h[3] << 16); o.z = (unsigned)h[4] | ((unsigned)h[5] << 16); o.w = (unsigned)h[6] | ((unsigned)h[7] << 16);
            *(u32x4*)(Vt + (size_t)(cb * 64 + c) * MT + row0 + t8) = o; }
        asm volatile("s_waitcnt lgkmcnt(0)" ::: "memory");
    }
}

template <int DV, bool WINDOW, bool SUB>
DI void attn_core(LAS unsigned char* lds, const bf16_t* Qp, int qpitch, const bf16_t* Kp, int kpitch, const bf16_t* Vtp,
                  int rowA, int nA, int rowB, int nB, int qpos0, int kposB, float bref, f32x16 (&o)[DV / 32], float& m_out, float& l_out) {
    constexpr int NDB = DV / 32, NVJ = DV / 64, KBUF = 64 * 144, VBUF = DV * 144, VOFF = 4 * KBUF;
    constexpr bool NEGM = SUB && (DV == 64);
    constexpr bool FIXED = true;
    constexpr float THR = 8.0f;
    int tid_o = threadIdx.x; asm volatile("" : "+v"(tid_o)); const int tid = tid_o, lane = tid & 63, wid = tid >> 6, r32 = lane & 31, hi = lane >> 5;
    const int srow = tid >> 3, sch = tid & 7;
    const int NT = nA + nB;
    bf16x8 qr[4];
    { const bf16_t* qrow = Qp + (size_t)(wid * 32 + r32) * qpitch + hi * 8;
#pragma unroll
      for (int d0 = 0; d0 < 4; ++d0) qr[d0] = *(const bf16x8*)(qrow + d0 * 16); }
#pragma unroll
    for (int db = 0; db < NDB; ++db)
#pragma unroll
        for (int r = 0; r < 16; ++r) o[db][r] = 0.f;
    f32x16 negm;
#pragma unroll
    for (int r = 0; r < 16; ++r) negm[r] = SUB ? -bref : 0.f;
    float mref = SUB ? bref : 0.f, l = 0.f;
    const float INF = __builtin_inff();
    u32x4 kst[2], vst[2][NVJ];
#define TROW(tt) ((tt) < nA ? rowA + (tt) * 64 : rowB + ((tt) - nA) * 64)
#define LOADK(tt, st) do { const int r0_ = TROW(tt); kst[st] = *(const u32x4*)(Kp + (size_t)(r0_ + srow) * kpitch + sch * 8); } while (0)
#define LOADV(tt, st) do { const int r0_ = TROW(tt); _Pragma("unroll") for (int j_ = 0; j_ < NVJ; ++j_) vst[st][j_] = *(const u32x4*)(Vtp + (size_t)(j_ * 64 + srow) * MT + r0_ + sch * 8); } while (0)
#define STOREK(buf, st) do { *(LAS u32x4*)(lds + (buf) * KBUF + srow * 144 + sch * 16) = kst[st]; } while (0)
#define STOREV(buf, st) do { _Pragma("unroll") for (int j_ = 0; j_ < NVJ; ++j_) *(LAS u32x4*)(lds + VOFF + (buf) * VBUF + (j_ * 64 + srow) * 144 + sch * 16) = vst[st][j_]; } while (0)
    const int rho = (r32 & ~12) | ((r32 & 4) << 1) | ((r32 & 8) >> 1);
    const int koff = rho * 144 + hi * 16, voff = VOFF + r32 * 144 + hi * 16;
    const int qp = qpos0 + wid * 32 + r32;
#define QK(PA, PB, buf) do { const LAS unsigned char* kb_ = lds + (buf) * KBUF + koff; if (NEGM) { PA = negm; PB = negm; } else { _Pragma("unroll") for (int r = 0; r < 16; ++r) { PA[r] = 0.f; PB[r] = 0.f; } } \
        _Pragma("unroll") for (int d0 = 0; d0 < 4; ++d0) { const bf16x8 k0_ = *(const LAS bf16x8*)(kb_ + d0 * 32), k1_ = *(const LAS bf16x8*)(kb_ + 32 * 144 + d0 * 32); \
            PA = __builtin_amdgcn_mfma_f32_32x32x16_bf16(k0_, qr[d0], PA, 0, 0, 0); PB = __builtin_amdgcn_mfma_f32_32x32x16_bf16(k1_, qr[d0], PB, 0, 0, 0); } } while (0)
#define BODY(PS0, PS1, PN0, PN1, tt, kbi, vbi) do { \
        if ((tt) + 1 < NT) QK(PN0, PN1, kbi); \
        if (WINDOW && (tt) >= nA) { const int kp0_ = kposB + ((tt) - nA) * 64 + 8 * hi - qp; \
            _Pragma("unroll") for (int r = 0; r < 16; ++r) { const int d_ = kp0_ + (r & 7) + 16 * (r >> 3); if (d_ > 128 || d_ < -128) PS0[r] = -1e30f; if (d_ + 32 > 128 || d_ + 32 < -128) PS1[r] = -1e30f; } } \
        if (!FIXED) { float mxa_ = __builtin_amdgcn_fmed3f(PS0[0], PS0[1], INF), mxb_ = __builtin_amdgcn_fmed3f(PS1[0], PS1[1], INF); \
        _Pragma("unroll") for (int r = 2; r < 16; ++r) { mxa_ = __builtin_amdgcn_fmed3f(mxa_, PS0[r], INF); mxb_ = __builtin_amdgcn_fmed3f(mxb_, PS1[r], INF); } \
        float mx_ = half_swap_max(__builtin_amdgcn_fmed3f(mxa_, mxb_, INF)); if (!NEGM) mx_ -= mref; \
        if ((tt) == 0 || __any(mx_ > THR)) { const float dl_ = ((tt) == 0) ? mx_ : (mx_ > 0.f ? mx_ : 0.f); mref += dl_; \
            if (NEGM) { _Pragma("unroll") for (int r = 0; r < 16; ++r) { PS0[r] -= dl_; PS1[r] -= dl_; PN0[r] -= dl_; PN1[r] -= dl_; negm[r] = -mref; } } \
            if ((tt) != 0) { const float al_ = __builtin_amdgcn_exp2f(-dl_); l *= al_; \
                _Pragma("unroll") for (int db = 0; db < NDB; ++db) _Pragma("unroll") for (int r = 0; r < 16; ++r) o[db][r] *= al_; } } } \
        float ls_ = 0.f; \
        _Pragma("unroll") for (int r = 0; r < 16; ++r) { PS0[r] = __builtin_amdgcn_exp2f((NEGM || !SUB) ? PS0[r] : PS0[r] - mref); PS1[r] = __builtin_amdgcn_exp2f((NEGM || !SUB) ? PS1[r] : PS1[r] - mref); ls_ += PS0[r] + PS1[r]; } \
        l += ls_; \
        bf16x8 pf_[4]; { u32x4 w_; \
          w_.x = pk2(PS0[0], PS0[1]); w_.y = pk2(PS0[2], PS0[3]); w_.z = pk2(PS0[4], PS0[5]); w_.w = pk2(PS0[6], PS0[7]); pf_[0] = __builtin_bit_cast(bf16x8, w_); \
          w_.x = pk2(PS0[8], PS0[9]); w_.y = pk2(PS0[10], PS0[11]); w_.z = pk2(PS0[12], PS0[13]); w_.w = pk2(PS0[14], PS0[15]); pf_[1] = __builtin_bit_cast(bf16x8, w_); \
          w_.x = pk2(PS1[0], PS1[1]); w_.y = pk2(PS1[2], PS1[3]); w_.z = pk2(PS1[4], PS1[5]); w_.w = pk2(PS1[6], PS1[7]); pf_[2] = __builtin_bit_cast(bf16x8, w_); \
          w_.x = pk2(PS1[8], PS1[9]); w_.y = pk2(PS1[10], PS1[11]); w_.z = pk2(PS1[12], PS1[13]); w_.w = pk2(PS1[14], PS1[15]); pf_[3] = __builtin_bit_cast(bf16x8, w_); } \
        { const LAS unsigned char* vb_ = lds + voff + (vbi) * VBUF; \
            \
          _Pragma("unroll") for (int dp = 0; dp < NDB / 2; ++dp) { \
            _Pragma("unroll") for (int sh = 0; sh < 2; ++sh) { bf16x8 va_[2], vb2_[2]; \
              _Pragma("unroll") for (int s = 0; s < 2; ++s) { va_[s] = *(const LAS bf16x8*)(vb_ + (2 * dp) * 32 * 144 + (2 * sh + s) * 32); vb2_[s] = *(const LAS bf16x8*)(vb_ + (2 * dp + 1) * 32 * 144 + (2 * sh + s) * 32); } \
              _Pragma("unroll") for (int s = 0; s < 2; ++s) { o[2 * dp] = __builtin_amdgcn_mfma_f32_32x32x16_bf16(va_[s], pf_[2 * sh + s], o[2 * dp], 0, 0, 0); \
                                                               o[2 * dp + 1] = __builtin_amdgcn_mfma_f32_32x32x16_bf16(vb2_[s], pf_[2 * sh + s], o[2 * dp + 1], 0, 0, 0); } } \
            if (DV > 64) __builtin_amdgcn_sched_barrier(0); } } \
        } while (0)
    f32x16 pa0, pa1, pb0, pb1;
    LOADK(0, 0); LOADK(1, 1); LOADV(0, 0); LOADV(1, 1); STOREK(0, 0); STOREK(1, 1); STOREV(0, 0); STOREV(1, 1); LOADK(2, 0); __syncthreads();
    QK(pa0, pa1, 0);
    STOREK(2, 0);
    __syncthreads();
#pragma unroll
    for (int r = 0; r < 16; ++r) { pb0[r] = 0.f; pb1[r] = 0.f; }
    for (int t = 0; t < NT; t += 2) {
        if (t + 3 < NT) LOADK(t + 3, 0);
        if (t + 4 < NT) LOADK(t + 4, 1);
        if (t + 2 < NT) LOADV(t + 2, 0);
        if (t + 3 < NT) LOADV(t + 3, 1);
        BODY(pa0, pa1, pb0, pb1, t, (t + 1) & 3, t & 3);
        BODY(pb0, pb1, pa0, pa1, t + 1, (t + 2) & 3, (t + 1) & 3);
        if (t + 3 < NT) STOREK((t + 3) & 3, 0);
        if (t + 4 < NT) STOREK((t + 4) & 3, 1);
        if (t + 2 < NT) STOREV((t + 2) & 3, 0);
        if (t + 3 < NT) STOREV((t + 3) & 3, 1);
        __syncthreads();
    }
#undef BODY
#undef TROW
#undef LOADK
#undef LOADV
#undef STOREK
#undef STOREV
#undef QK
    m_out = mref; l_out = half_swap_sum(l);
}

template <bool WINDOW>
DI float rowmax_core(LAS unsigned char* lds, const bf16_t* Qp, int qpitch, const bf16_t* Kp, int kpitch, int rowA, int nA, int rowB, int nB, int qpos0, int kposB) {
    int tid_o = threadIdx.x; asm volatile("" : "+v"(tid_o)); const int tid = tid_o, lane = tid & 63, wid = tid >> 6, r32 = lane & 31, hi = lane >> 5;
    const int srow = tid >> 3, sch = tid & 7; const int NT = nA + nB;
    bf16x8 qr[4];
    { const bf16_t* qrow = Qp + (size_t)(wid * 32 + r32) * qpitch + hi * 8;
#pragma unroll
      for (int d0 = 0; d0 < 4; ++d0) qr[d0] = *(const bf16x8*)(qrow + d0 * 16); }
    const int rho = (r32 & ~12) | ((r32 & 4) << 1) | ((r32 & 8) >> 1);
    const int koff = rho * 144 + hi * 16; const int qp = qpos0 + wid * 32 + r32;
    float mx = -1e30f;
    for (int t = 0; t < NT; ++t) {
        const int r0 = t < nA ? rowA + t * 64 : rowB + (t - nA) * 64;
        const u32x4 kv = *(const u32x4*)(Kp + (size_t)(r0 + srow) * kpitch + sch * 8);
        __syncthreads();
        *(LAS u32x4*)(lds + srow * 144 + sch * 16) = kv;
        __syncthreads();
        f32x16 p0, p1;
#pragma unroll
        for (int r = 0; r < 16; ++r) { p0[r] = 0.f; p1[r] = 0.f; }
#pragma unroll
        for (int d0 = 0; d0 < 4; ++d0) { const bf16x8 k0 = *(const LAS bf16x8*)(lds + koff + d0 * 32), k1 = *(const LAS bf16x8*)(lds + koff + 32 * 144 + d0 * 32);
            p0 = __builtin_amdgcn_mfma_f32_32x32x16_bf16(k0, qr[d0], p0, 0, 0, 0); p1 = __builtin_amdgcn_mfma_f32_32x32x16_bf16(k1, qr[d0], p1, 0, 0, 0); }
        if (WINDOW && t >= nA) { const int kp0 = kposB + (t - nA) * 64 + 8 * hi - qp;
#pragma unroll
            for (int r = 0; r < 16; ++r) { const int d = kp0 + (r & 7) + 16 * (r >> 3); if (d > 128 || d < -128) p0[r] = -1e30f; if (d + 32 > 128 || d + 32 < -128) p1[r] = -1e30f; } }
#pragma unroll
        for (int r = 0; r < 16; ++r) mx = fmaxf(mx, fmaxf(p0[r], p1[r]));
    }
    __syncthreads();
    return half_swap_max(mx);
}

DI float score_bound(const float* gq, const float* gk) {
    int lane = threadIdx.x & 63; asm volatile("" : "+v"(lane));
    float a = fabsf(gq[lane]), b = fabsf(gk[lane]);
#pragma unroll
    for (int o = 1; o < 64; o <<= 1) { a = fmaxf(a, __shfl_xor(a, o)); b = fmaxf(b, __shfl_xor(b, o)); }
    const float bound = 64.0f * a * b * C2 * 1.02f + 0.25f;
    const float r = (bound < 40.0f) ? bound : -1.0f;
    return __uint_as_float(__builtin_amdgcn_readfirstlane(__float_as_uint(r)));
}

template <bool WINDOW>
DI void attn_gqa_phase(const Params& P, LAS unsigned char* lds, const float* sink, const float* gq, const float* gk) {
    int tid_o = threadIdx.x; asm volatile("" : "+v"(tid_o)); const int tid = tid_o, lane = tid & 63, wid = tid >> 6, r32 = lane & 31, hi = lane >> 5;
    const bf16_t* QKV = (const bf16_t*)(P.ws + WS_BIG); const bf16_t* Vt = (const bf16_t*)(P.ws + WS_VT); bf16_t* ATT = (bf16_t*)(P.ws + WS_ATT);
    const int NU = WINDOW ? 1024 : 1056;
    const float bref = score_bound(gq, gk);
    for (int L = bid(); L < NU; L += gridDim.x) {
        int b, hq, qrow0, rowA, nA, rowB, nB, qpos0 = 0, kposB = 0;
        if (L < 1024) { const int combo = L & 7, rest = L >> 3; b = combo >> 2; const int kvh = combo & 3; hq = kvh * 4 + (rest >> 5); const int qb = rest & 31;
            qrow0 = b * SEQ + qb * 256; rowA = ML + b * CTXL; nA = 4;
            if (WINDOW) { int s = qb * 256 - 128; if (s < 0) s = 0; int e = qb * 256 + 384; if (e > SEQ) e = SEQ; rowB = b * SEQ + s; nB = (e - s) >> 6; qpos0 = qb * 256; kposB = s; }
            else { rowB = b * SEQ; nB = SEQ / 64; } }
        else { const int j = L - 1024; b = j >> 4; hq = j & 15; qrow0 = ML + b * CTXL; rowA = qrow0; nA = 4; rowB = 0; nB = 0; }
        const int kvh = hq >> 2;
        f32x16 o[2]; float m, l;
        if (bref >= 0.f) attn_core<64, WINDOW, false>(lds, QKV + (size_t)qrow0 * 1536 + hq * 64, 1536, QKV + 1024 + kvh * 64, 1536, Vt + (size_t)(kvh * 64) * MT, rowA, nA, rowB, nB, qpos0, kposB, 0.f, o, m, l);
        else { const float mr = rowmax_core<WINDOW>(lds, QKV + (size_t)qrow0 * 1536 + hq * 64, 1536, QKV + 1024 + kvh * 64, 1536, rowA, nA, rowB, nB, qpos0, kposB);
            attn_core<64, WINDOW, true>(lds, QKV + (size_t)qrow0 * 1536 + hq * 64, 1536, QKV + 1024 + kvh * 64, 1536, Vt + (size_t)(kvh * 64) * MT, rowA, nA, rowB, nB, qpos0, kposB, mr, o, m, l); }
        if (WINDOW) l += __builtin_amdgcn_exp2f(sink[hq] * LOG2E - m);
        const float inv = 1.0f / l;
        bf16_t* op = ATT + (size_t)(qrow0 + wid * 32 + r32) * 1024 + hq * 64 + 4 * hi;
#pragma unroll
        for (int db = 0; db < 2; ++db)
#pragma unroll
            for (int g = 0; g < 4; ++g) { u32x2 w; w.x = pk2(o[db][4 * g] * inv, o[db][4 * g + 1] * inv); w.y = pk2(o[db][4 * g + 2] * inv, o[db][4 * g + 3] * inv); *(u32x2*)(op + 32 * db + 8 * g) = w; }
    }
}

DI void attn_diff_phase(const Params& P, LAS unsigned char* lds) {
    int tid_o = threadIdx.x; asm volatile("" : "+v"(tid_o)); const int tid = tid_o, lane = tid & 63, wid = tid >> 6, r32 = lane & 31, hi = lane >> 5;
    const bf16_t* QKV = (const bf16_t*)(P.ws + WS_BIG); const bf16_t* Vt = (const bf16_t*)(P.ws + WS_VT); bf16_t* ATT = (bf16_t*)(P.ws + WS_ATT);
    float* stash = (float*)(P.ws + WS_XN) + ((size_t)(bid() * 8 + wid) * 64 + lane) * 64;
    const float lam = ((const float*)(P.ws + WS_MODV))[73728];
    const float lam_init = 0.8f - 0.6f * 0.5488116360940264f;
    const float* sg = P.in[29];
    const float bref = score_bound(P.in[23], P.in[24]);
    for (int L = bid(); L < 528; L += gridDim.x) {
        int b, h, qrow0, rowA, nA, rowB, nB;
        if (L < 512) { const int combo = L & 7, rest = L >> 3; const int pair = combo * 2 + (rest >> 5), qb = rest & 31; b = pair >> 3; h = pair & 7;
            qrow0 = b * SEQ + qb * 256; rowA = ML + b * CTXL; nA = 4; rowB = b * SEQ; nB = SEQ / 64; }
        else { const int j = L - 512; b = j >> 3; h = j & 7; qrow0 = ML + b * CTXL; rowA = qrow0; nA = 4; rowB = 0; nB = 0; }
        f32x16 o[4]; float m, l;
#pragma unroll 1
        for (int comp = 0; comp < 2; ++comp) {
            if (bref >= 0.f) attn_core<128, false, false>(lds, QKV + (size_t)qrow0 * 3072 + h * 128 + comp * 64, 3072, QKV + 1024 + h * 128 + comp * 64, 3072, Vt + (size_t)(h * 128) * MT, rowA, nA, rowB, nB, 0, 0, 0.f, o, m, l);
            else { const float mr = rowmax_core<false>(lds, QKV + (size_t)qrow0 * 3072 + h * 128 + comp * 64, 3072, QKV + 1024 + h * 128 + comp * 64, 3072, rowA, nA, rowB, nB, 0, 0);
                attn_core<128, false, true>(lds, QKV + (size_t)qrow0 * 3072 + h * 128 + comp * 64, 3072, QKV + 1024 + h * 128 + comp * 64, 3072, Vt + (size_t)(h * 128) * MT, rowA, nA, rowB, nB, 0, 0, mr, o, m, l); }
            if (comp == 0) { const float inv = 1.0f / l;
#pragma unroll
                for (int db = 0; db < 4; ++db)
#pragma unroll
                    for (int g = 0; g < 4; ++g) *(f32x4*)(stash + db * 16 + 4 * g) = (f32x4){o[db][4 * g] * inv, o[db][4 * g + 1] * inv, o[db][4 * g + 2] * inv, o[db][4 * g + 3] * inv};
            } else { const float inv = lam / l; float ss = 0.f;
#pragma unroll
                for (int db = 0; db < 4; ++db)
#pragma unroll
                    for (int g = 0; g < 4; ++g) { const f32x4 s0 = *(const f32x4*)(stash + db * 16 + 4 * g);
#pragma unroll
                        for (int e = 0; e < 4; ++e) { const float v = s0[e] - o[db][4 * g + e] * inv; o[db][4 * g + e] = v; ss += v * v; } }
                ss = half_swap_sum(ss);
                const float rs = (1.0f - lam_init) / sqrtf(ss * (1.0f / 128.0f) + EPS);
                bf16_t* op = ATT + (size_t)(qrow0 + wid * 32 + r32) * 1024 + h * 128 + 4 * hi;
#pragma unroll
                for (int db = 0; db < 4; ++db)
#pragma unroll
                    for (int g = 0; g < 4; ++g) { const f32x4 gg = *(const f32x4*)(sg + 32 * db + 8 * g + 4 * hi);
                        u32x2 w; w.x = pk2(o[db][4 * g] * rs * gg.x, o[db][4 * g + 1] * rs * gg.y); w.y = pk2(o[db][4 * g + 2] * rs * gg.z, o[db][4 * g + 3] * rs * gg.w); *(u32x2*)(op + 32 * db + 8 * g) = w; }
            }
        }
    }
}

DI void conv_phase(const Params& P, LAS unsigned char* lds, const bf16_t* U, bf16_t* OUT) {
    int tid_o = threadIdx.x; asm volatile("" : "+v"(tid_o)); const int tid = tid_o, lane = tid & 63, wid = tid >> 6;
    const int c0 = 2 * tid;
    float w0[31], w1[31];
#pragma unroll
    for (int j = 0; j < 31; ++j) { const f32x2 w = *(const f32x2*)(P.in[16] + j * 1024 + c0); w0[j] = w.x; w1[j] = w.y; }
    const f32x2 bdw = *(const f32x2*)(P.in[17] + c0), lng = *(const f32x2*)(P.in[18] + c0), lnb = *(const f32x2*)(P.in[19] + c0);
    LAS float* red = (LAS float*)(lds + 62 * 2048);
    for (int item = bid(); item < MT / 32; item += gridDim.x) {
        const int tok0 = item * 32; int s0, s1;
        if (tok0 < ML) { s0 = (tok0 >> 13) << 13; s1 = s0 + SEQ; } else { s0 = ML + (((tok0 - ML) >> 8) << 8); s1 = s0 + CTXL; }
        for (int ci = tid; ci < 62 * 128; ci += 512) { const int rr = ci >> 7, ch = ci & 127; const int tk = tok0 - 15 + rr;
            u32x4 v = (u32x4){0u, 0u, 0u, 0u};
            if (tk >= s0 && tk < s1) v = *(const u32x4*)(U + (size_t)tk * 1024 + ch * 8);
            *(LAS u32x4*)(lds + rr * 2048 + ch * 16) = v; }
        __syncthreads();
        for (int tg = 0; tg < 8; ++tg) {
            float a0[4], a1[4];
#pragma unroll
            for (int i = 0; i < 4; ++i) { a0[i] = bdw.x; a1[i] = bdw.y; }
            const LAS unsigned char* base = lds + (tg * 4) * 2048 + c0 * 2;
#pragma unroll
            for (int rr = 0; rr < 34; ++rr) { const unsigned u2 = *(const LAS unsigned*)(base + rr * 2048); const float x0 = bflo(u2), x1 = bfhi(u2);
#pragma unroll
                for (int i = 0; i < 4; ++i) { const int j = rr - i; if (j >= 0 && j <= 30) { a0[i] += w0[j] * x0; a1[i] += w1[j] * x1; } } }
            float st[8];
#pragma unroll
            for (int i = 0; i < 4; ++i) { st[2 * i] = wave_sum(a0[i] + a1[i]); st[2 * i + 1] = wave_sum(a0[i] * a0[i] + a1[i] * a1[i]); }
            LAS float* rb = red + (tg & 1) * 64;
            if (lane == 0) {
#pragma unroll
                for (int i = 0; i < 8; ++i) rb[wid * 8 + i] = st[i];
            }
            __syncthreads();
#pragma unroll
            for (int i = 0; i < 4; ++i) { float s = 0.f, q = 0.f;
#pragma unroll
                for (int w = 0; w < 8; ++w) { s += rb[w * 8 + 2 * i]; q += rb[w * 8 + 2 * i + 1]; }
                const float mean = s * (1.0f / 1024.0f); float var = q * (1.0f / 1024.0f) - mean * mean; var = var > 0.f ? var : 0.f;
                const float rs = 1.0f / sqrtf(var + EPS);
                float y0 = (a0[i] - mean) * rs * lng.x + lnb.x, y1 = (a1[i] - mean) * rs * lng.y + lnb.y;
                y0 = y0 / (1.0f + __expf(-y0)); y1 = y1 / (1.0f + __expf(-y1));
                *(unsigned*)(OUT + (size_t)(tok0 + tg * 4 + i) * 1024 + c0) = pk2(y0, y1); }
        }
        __syncthreads();
    }
}


template <int NB, class F>
DI void small_gemm(LAS unsigned char* lds, const bf16_t* A, int lda, const bf16_t* Bt, int ldb, int N, int KC, int rot, const F& f) {
    constexpr int ABUF = 64 * 144, BBUF = 128 * NB * 144, BOFF = 2 * ABUF;
    int tid_o = threadIdx.x; asm volatile("" : "+v"(tid_o)); const int tid = tid_o, lane = tid & 63, wid = tid >> 6, r32 = lane & 31, hi = lane >> 5, wr = wid >> 2, wc = wid & 3;
    const int srow = tid >> 3, sch = tid & 7;
    const int G = gridDim.x; const int nct = N / (128 * NB), nitems = 8 * nct * KC;
    int first = (int)bid() - rot; if (first < 0) first += G;
    const int aoff = (32 * wr + r32) * 144 + hi * 16, boff = BOFF + (32 * wc + r32) * 144 + hi * 16;
    for (int it = first; it < nitems; it += G) {
        const int kc = it % KC, t2 = it / KC, rt = t2 & 7, ct = t2 >> 3;
        const bf16_t* Ap = A + (size_t)(rt * 64 + srow) * lda + kc * 1024 + sch * 8;
        const bf16_t* Bp = Bt + (size_t)(ct * 128 * NB + srow) * ldb + kc * 1024 + sch * 8;
        f32x16 acc[NB];
#pragma unroll
        for (int nb = 0; nb < NB; ++nb)
#pragma unroll
            for (int r = 0; r < 16; ++r) acc[nb][r] = 0.f;
#define SG_BAR() do { asm volatile("s_waitcnt lgkmcnt(0)" ::: "memory"); __builtin_amdgcn_s_barrier(); asm volatile("" ::: "memory"); } while (0)
        u32x4 ast[4], bst[4][2 * NB];
#define SG_LOAD(ks, st) do { ast[st] = *(const u32x4*)(Ap + (ks) * 64); _Pragma("unroll") for (int j_ = 0; j_ < 2 * NB; ++j_) bst[st][j_] = *(const u32x4*)(Bp + (size_t)(j_ * 64) * ldb + (ks) * 64); } while (0)
#define SG_STORE(buf, st) do { *(LAS u32x4*)(lds + (buf) * ABUF + srow * 144 + sch * 16) = ast[st]; \
        _Pragma("unroll") for (int j_ = 0; j_ < 2 * NB; ++j_) *(LAS u32x4*)(lds + BOFF + (buf) * BBUF + (j_ * 64 + srow) * 144 + sch * 16) = bst[st][j_]; } while (0)
        SG_LOAD(0, 0); SG_LOAD(1, 1); SG_LOAD(2, 2); SG_LOAD(3, 3); SG_STORE(0, 0); SG_BAR();
        for (int k4 = 0; k4 < 16; k4 += 4) {
#pragma unroll
            for (int d = 0; d < 4; ++d) { const int ks = k4 + d; const int buf = d & 1;
                if (ks + 4 < 16) SG_LOAD(ks + 4, d);
#pragma unroll
                for (int kk = 0; kk < 4; ++kk) { const bf16x8 a = *(const LAS bf16x8*)(lds + buf * ABUF + aoff + kk * 32);
#pragma unroll
                    for (int nb = 0; nb < NB; ++nb) { const bf16x8 b = *(const LAS bf16x8*)(lds + buf * BBUF + boff + nb * 128 * 144 + kk * 32); acc[nb] = __builtin_amdgcn_mfma_f32_32x32x16_bf16(b, a, acc[nb], 0, 0, 0); } }
                if (ks + 1 < 16) SG_STORE(buf ^ 1, (d + 1) & 3);
                SG_BAR();
            }
        }
#undef SG_BAR
#undef SG_LOAD
#undef SG_STORE
        f(rt * 64 + 32 * wr + r32, ct, kc, wc, hi, acc);
    }
}
struct FSt { bf16_t* O; int ldc; int act;
    DI void operator()(int row, int ct, int kc, int wc, int hi, const f32x16 (&acc)[1]) const {
#pragma unroll
        for (int g = 0; g < 4; ++g) { float v[4];
#pragma unroll
            for (int e = 0; e < 4; ++e) { v[e] = acc[0][4 * g + e]; if (act == 2) { v[e] = v[e] > 0.f ? v[e] : 0.f; v[e] *= v[e]; } }
            u32x2 w; w.x = pk2(v[0], v[1]); w.y = pk2(v[2], v[3]); *(u32x2*)(O + (size_t)row * ldc + ct * 128 + 32 * wc + 8 * g + 4 * hi) = w; } } };
struct FGlu { bf16_t* O; const float* bias;
    DI void operator()(int row, int ct, int kc, int wc, int hi, const f32x16 (&acc)[2]) const {
#pragma unroll
        for (int g = 0; g < 4; ++g) { const int ch = ct * 128 + 32 * wc + 8 * g + 4 * hi; const f32x4 ba = *(const f32x4*)(bias + ch), bg = *(const f32x4*)(bias + 1024 + ch);
            float r[4];
#pragma unroll
            for (int e = 0; e < 4; ++e) r[e] = (acc[0][4 * g + e] + ba[e]) / (1.0f + __expf(-(acc[1][4 * g + e] + bg[e])));
            u32x2 w; w.x = pk2(r[0], r[1]); w.y = pk2(r[2], r[3]); *(u32x2*)(O + (size_t)row * 1024 + ch) = w; } } };
struct FRes { float* X; const float* gate; const float* bias; int atomic;
    DI void operator()(int row, int ct, int kc, int wc, int hi, const f32x16 (&acc)[1]) const {
#pragma unroll
        for (int g = 0; g < 4; ++g) { const int c = ct * 128 + 32 * wc + 8 * g + 4 * hi;
            float* p = X + (size_t)row * 1024 + c; const f32x4 gv = *(const f32x4*)(gate + c);
            f32x4 val = (f32x4){acc[0][4 * g], acc[0][4 * g + 1], acc[0][4 * g + 2], acc[0][4 * g + 3]}; if (bias && kc == 0) val = val + *(const f32x4*)(bias + c);
            val = val * gv;
            if (atomic) {
#pragma unroll
                for (int e = 0; e < 4; ++e) unsafeAtomicAdd(p + e, val[e]);
            } else { *(f32x4*)p = *(const f32x4*)p + val; } } } };
struct FQkv { bf16_t* O; int pitch; int nk; const float* gq; const float* gk; bf16_t* Vt; float qscale;
    DI void operator()(int row, int ct, int kc, int wc, int hi, const f32x16 (&acc)[2]) const {
        if (ct < 4 + nk) { const bool isq = ct < 4; const float* g = isq ? gq : gk;
            float ss = 0.f;
#pragma unroll
            for (int r = 0; r < 16; ++r) ss += acc[0][r] * acc[0][r] + acc[1][r] * acc[1][r];
            ss = half_swap_sum(ss);
            const float rs = (isq ? qscale : 1.0f) / sqrtf(ss * (1.0f / 64.0f) + EPS);
#pragma unroll
            for (int bj = 0; bj < 2; ++bj)
#pragma unroll
                for (int gi = 0; gi < 4; ++gi) { const int d0 = 32 * bj + 8 * gi + 4 * hi; const f32x4 gg = *(const f32x4*)(g + d0);
                    u32x2 w; w.x = pk2(acc[bj][4 * gi] * rs * gg[0], acc[bj][4 * gi + 1] * rs * gg[1]); w.y = pk2(acc[bj][4 * gi + 2] * rs * gg[2], acc[bj][4 * gi + 3] * rs * gg[3]);
                    *(u32x2*)(O + (size_t)row * pitch + ct * 256 + wc * 64 + d0) = w; }
        } else { const int vc0 = (ct - 4 - nk) * 256 + wc * 64 + 4 * hi;
#pragma unroll
            for (int bj = 0; bj < 2; ++bj)
#pragma unroll
                for (int r = 0; r < 16; ++r) { const int vc = vc0 + 32 * bj + (r & 3) + 8 * (r >> 2); const unsigned w = pk2(acc[bj][r], 0.f);
                    Vt[(size_t)vc * MT + row] = (bf16_t)(w & 0xffffu); } } } };

#ifndef PHM
#define PHM 0xffff
#endif
#define EN(k) ((PHM >> (k)) & 1)
#ifndef DBL
#define DBL 0
#endif
#define DB(k) ((DBL >> (k)) & 1)
template <class Epi> DI void run_gemm(LAS unsigned char* lds, const bf16_t* A, const bf16_t* Bt, int M, int N, int K, const Epi& E) {
    pg8::Gemm g{A, Bt, M, N, K}; pg8::StaticOrder S; S.init(M, N, (int)gridDim.x, (int)bid());
    pg8::gemm_phase<Epi, pg8::StaticOrder, true, true>(lds, g, S, E);
}

#define XB_TMO      128
#define XB_XCNT(j)  (256  + 64 * (j))
#define XB_XSUB(j)  (1280 + 64 * (j))
#define XB_XGEN(j)  (2304 + 64 * (j))
#define XB_TOP      3328
#define XB_TOPGEN   3392
#define XCD_BAR_WORDS 3456
#define XB_SPIN_CAP (1u << 18)

__device__ __forceinline__ unsigned xb_ld(unsigned* p)              { return __hip_atomic_load(p, __ATOMIC_RELAXED, __HIP_MEMORY_SCOPE_AGENT); }
__device__ __forceinline__ unsigned xb_add(unsigned* p, unsigned v) { return __hip_atomic_fetch_add(p, v, __ATOMIC_RELAXED, __HIP_MEMORY_SCOPE_AGENT); }
__device__ __forceinline__ unsigned xb_xcc_id() { return (unsigned)__builtin_amdgcn_s_getreg((3 << 11) | 20) & 0xFu; }
#define XB_SPIN(cond, bar) do { unsigned _sp = 0; while (cond) { __builtin_amdgcn_s_sleep(1); \
    if ((++_sp & 255u) == 0u) { if (xb_ld(&(bar)[XB_TMO])) break; if (_sp > XB_SPIN_CAP) { atomicAdd(&(bar)[XB_TMO], 1u); break; } } } } while (0)

struct XcdBarrier {
    unsigned* bar; unsigned x;
    volatile LAS unsigned* st;
};

__device__ __forceinline__ XcdBarrier xcd_barrier_post(unsigned* bar, volatile LAS unsigned* st) {
    XcdBarrier b; b.bar = bar; b.x = xb_xcc_id(); b.st = st;
    if (threadIdx.x == 0) (void)xb_add(&bar[XB_XCNT(b.x)], 1u);
    return b;
}
__device__ __forceinline__ void xcd_barrier_complete(unsigned* bar, unsigned x, unsigned& nloc, unsigned& nx) {
    const unsigned G = gridDim.x * gridDim.y * gridDim.z;
    unsigned sum, cnt, mine, sp = 0u;
    for (;;) {
        sum = 0u; cnt = 0u; mine = 0u;
#pragma unroll
        for (unsigned j = 0; j < 16; ++j) { const unsigned c = xb_ld(&bar[XB_XCNT(j)]); sum += c; cnt += (c > 0u) ? 1u : 0u; mine = (j == x) ? c : mine; }
        if (sum == G) break;
        __builtin_amdgcn_s_sleep(1);
        if ((++sp & 255u) == 0u) { if (xb_ld(&bar[XB_TMO])) break; if (sp > XB_SPIN_CAP) { atomicAdd(&bar[XB_TMO], 1u); break; } }
    }
    nloc = mine > 0u ? mine : 1u; nx = cnt > 0u ? cnt : 1u;
}

__device__ __forceinline__ void xcd_barrier(const XcdBarrier& b) {
    asm volatile("s_waitcnt vmcnt(0)" ::: "memory");
    __syncthreads();
    if (threadIdx.x == 0) {
        unsigned* bar = b.bar;
        __builtin_amdgcn_s_waitcnt(0);
        unsigned nloc = b.st[0], nx = b.st[1];
        if (nloc == 0u) { xcd_barrier_complete(bar, b.x, nloc, nx); b.st[0] = nloc; b.st[1] = nx; }
        const unsigned old = xb_add(&bar[XB_XSUB(b.x)], 1u);
        const unsigned gen = old / nloc;
        if (old + 1u == (gen + 1u) * nloc) {
            __builtin_amdgcn_fence(__ATOMIC_RELEASE, "agent");
            asm volatile("s_waitcnt vmcnt(0)" ::: "memory");
            const unsigned og = xb_add(&bar[XB_TOP], 1u);
            const unsigned tg = og / nx;
            if (og + 1u == (tg + 1u) * nx) xb_add(&bar[XB_TOPGEN], 1u);
            else XB_SPIN(xb_ld(&bar[XB_TOPGEN]) == tg, bar);
            __builtin_amdgcn_fence(__ATOMIC_ACQUIRE, "agent");
            xb_add(&bar[XB_XGEN(b.x)], 1u);
            asm volatile("s_waitcnt vmcnt(0)" ::: "memory");
        } else {
            XB_SPIN(xb_ld(&bar[XB_XGEN(b.x)]) == gen, bar);
            __builtin_amdgcn_fence(__ATOMIC_ACQUIRE, "agent");
            asm volatile("s_waitcnt vmcnt(0)" ::: "memory");
        }
    }
    __syncthreads();
}

constexpr size_t WS_BAR = 512 * 1024;
constexpr int MISC_OFF = 131072 + 320;
__global__ void __launch_bounds__(512) fwd_megakernel(Params P) {
    extern __shared__ __attribute__((aligned(16))) unsigned char lds_raw[];
    LAS unsigned char* lds = (LAS unsigned char*)lds_raw;
    cg::grid_group grid = cg::this_grid();
    unsigned char* ws0 = P.ws;
    { unsigned* bw = (unsigned*)(ws0 + WS_BAR);
      if (bid() == 0) for (int i = threadIdx.x; i < XCD_BAR_WORDS; i += 512) __hip_atomic_store(bw + i, 0u, __ATOMIC_RELAXED, __HIP_MEMORY_SCOPE_AGENT);
      volatile LAS unsigned* misc = (volatile LAS unsigned*)(lds + MISC_OFF);
      if (threadIdx.x < 32) misc[threadIdx.x] = 0u; }
    if (EN(0)) prologue(P, lds);
    __threadfence();
    grid.sync();
    (void)xcd_barrier_post((unsigned*)(ws0 + WS_BAR), (volatile LAS unsigned*)(lds + MISC_OFF) + 8);
#define GBAR() do { XcdBarrier b_; b_.bar = (unsigned*)(P.ws + WS_BAR); b_.x = xb_xcc_id(); b_.st = (volatile LAS unsigned*)(lds + MISC_OFF) + 8; xcd_barrier(b_); } while (0)
#pragma unroll 1
    for (int l = 0; l < 4; ++l) {
        unsigned char* ws = P.ws; asm volatile("" : "+s"(ws));
#define X ((float*)(ws + WS_X))
#define XN ((bf16_t*)(ws + WS_XN))
#define BIG ((bf16_t*)(ws + WS_BIG))
#define ATT ((bf16_t*)(ws + WS_ATT))
#define MODV ((const float*)(ws + WS_MODV))
        const int M2 = (l == 3) ? ML : MT;
        if (EN(1)) norm_phase(P, l, 0, MT, l == 0);
        if (DB(3)) { GBAR(); norm_phase(P, l, 0, MT, l == 0); }
        GBAR(); asm volatile("" : "+s"(ws));
        if (!EN(2)) {} else if (l == 1) { run_gemm(lds, XN, (const bf16_t*)(ws + W_PW1), ML, 2048, 1024, pg8::EpiGlu{BIG, P.in[15]});
            small_gemm<2>(lds, XN + (size_t)ML * 1024, 1024, (const bf16_t*)(ws + W_PW1), 1024, 2048, 1, 0, FGlu{BIG + (size_t)ML * 1024, P.in[15]}); }
        else { const int Nq = (l == 2) ? 3072 : 1536, nk = (l == 2) ? 4 : 1; const bf16_t* Wq = (const bf16_t*)(ws + (l == 0 ? W_QKV0 : l == 2 ? W_QKV2 : W_QKV3));
               const float* gq = P.in[l == 0 ? 11 : l == 2 ? 23 : 32]; const float* gk = P.in[l == 0 ? 12 : l == 2 ? 24 : 33]; bf16_t* Vt = (bf16_t*)(ws + WS_VT);
               run_gemm(lds, XN, Wq, (l == 2) ? ML : MT, Nq, 1024, pg8::EpiQKV{BIG, Nq, nk, gq, gk, (const float*)(ws + WS_ROPE), Vt, MT, C2, EPS});
               if (l == 2) small_gemm<2>(lds, XN + (size_t)ML * 1024, 1024, Wq, 1024, Nq, 1, 0, FQkv{BIG + (size_t)ML * Nq, Nq, nk, gq, gk, Vt + ML, C2}); }
        GBAR(); asm volatile("" : "+s"(ws));
        if (l == 1) { if (EN(3)) conv_phase(P, lds, BIG, ATT); if (DB(5)) { GBAR(); conv_phase(P, lds, BIG, ATT); } }
        else {
            if (l == 0) { if (EN(5)) attn_gqa_phase<false>(P, lds, nullptr, P.in[11], P.in[12]); if (DB(0)) { GBAR(); attn_gqa_phase<false>(P, lds, nullptr, P.in[11], P.in[12]); } }
            else if (l == 2) { if (EN(6)) attn_diff_phase(P, lds); if (DB(1)) { GBAR(); attn_diff_phase(P, lds); } }
            else { if (EN(7)) attn_gqa_phase<true>(P, lds, P.in[34], P.in[32], P.in[33]); if (DB(5)) { GBAR(); attn_gqa_phase<true>(P, lds, P.in[34], P.in[32], P.in[33]); } }
        }
        GBAR(); asm volatile("" : "+s"(ws));
        { const bf16_t* Wo = (const bf16_t*)(ws + (l == 0 ? W_O0 : l == 1 ? W_PW2 : l == 2 ? W_O2 : W_O3)); const float* gate = MODV + (size_t)l * 3 * 6144 + 2048; const float* bo = l == 1 ? P.in[21] : nullptr;
          if (DB(6)) { run_gemm(lds, ATT, Wo, ML, 1024, 1024, pg8::EpiRes{X, P.out, gate, bo}); GBAR(); }
          if (EN(8)) { run_gemm(lds, ATT, Wo, ML, 1024, 1024, pg8::EpiRes{X, X, gate, bo});
              if (l < 3) small_gemm<1>(lds, ATT + (size_t)ML * 1024, 1024, Wo, 1024, 1024, 1, 0, FRes{X + (size_t)ML * 1024, gate + 2 * 6144, bo, 0}); } }
        GBAR(); asm volatile("" : "+s"(ws));
        if (EN(1)) norm_phase(P, l, 1, M2, 0);
        if (DB(3)) { GBAR(); norm_phase(P, l, 1, M2, 0); }
        GBAR(); asm volatile("" : "+s"(ws));
        { const bf16_t* Wu = (const bf16_t*)(ws + W_UP) + (size_t)l * 4096 * 1024;
          if (DB(2)) { run_gemm(lds, XN, Wu, ML, 4096, 1024, pg8::EpiSt<2>{BIG, 4096}); GBAR(); }
          if (EN(9)) { run_gemm(lds, XN, Wu, ML, 4096, 1024, pg8::EpiSt<2>{BIG, 4096});
              if (l < 3) small_gemm<1>(lds, XN + (size_t)ML * 1024, 1024, Wu, 1024, 4096, 1, 0, FSt{BIG + (size_t)ML * 4096, 4096, 2}); } }
        GBAR(); asm volatile("" : "+s"(ws));
        { const bf16_t* Wd = (const bf16_t*)(ws + W_DN) + (size_t)l * 4096 * 1024; const float* gate = MODV + (size_t)l * 3 * 6144 + 5120;
          if (DB(6)) { run_gemm(lds, BIG, Wd, ML, 1024, 4096, pg8::EpiRes{X, P.out, gate, nullptr}); GBAR(); }
          if (EN(10)) { run_gemm(lds, BIG, Wd, ML, 1024, 4096, pg8::EpiRes{X, l == 3 ? P.out : X, gate, nullptr});
              if (l < 3) small_gemm<1>(lds, BIG + (size_t)ML * 4096, 4096, Wd, 4096, 1024, 4, 0, FRes{X + (size_t)ML * 1024, gate + 2 * 6144, nullptr, 1}); } }
        if (l < 3) GBAR();
    }
}
#undef X
#undef XN
#undef BIG
#undef ATT
#undef MODV

extern "C" void kernel_launch(void* const* d_in, const int* in_sizes, int n_in, void* d_out, int out_size, void* d_ws, size_t ws_size, hipStream_t stream) {
    static int grid_blocks = 0;
    if (grid_blocks == 0) {
        if (n_in != 36 || out_size != ML * DM || ws_size < WS_END) { fprintf(stderr, "kernel_launch: unexpected problem (n_in %d, out %d, ws %zu)\n", n_in, out_size, ws_size); grid_blocks = -1; return; }
        int dev = 0, cus = 0, per_cu = 0;
        hipGetDevice(&dev); hipDeviceGetAttribute(&cus, hipDeviceAttributeMultiprocessorCount, dev);
        hipFuncSetAttribute((const void*)fwd_megakernel, hipFuncAttributeMaxDynamicSharedMemorySize, LDS_BYTES);
        if (hipOccupancyMaxActiveBlocksPerMultiprocessor(&per_cu, (const void*)fwd_megakernel, 512, LDS_BYTES) != hipSuccess || per_cu < 1) { fprintf(stderr, "kernel_launch: occupancy query gives %d\n", per_cu); per_cu = 1; }
        (void)hipGetLastError();
        grid_blocks = cus * 1;
        if (grid_blocks > 256) grid_blocks = 256;
        fprintf(stderr, "kernel_launch: cus %d per_cu %d grid %d\n", cus, per_cu, grid_blocks);
    }
    if (grid_blocks < 0) return;
    Params p{};
    for (int i = 0; i < 36; ++i) p.in[i] = (const float*)d_in[i];
    p.out = (float*)d_out; p.ws = (unsigned char*)d_ws;
    void* args[] = {&p};
    hipError_t e = hipLaunchCooperativeKernel((const void*)fwd_megakernel, dim3(grid_blocks), dim3(512), args, LDS_BYTES, stream);
    if (e != hipSuccess) fprintf(stderr, "cooperative launch failed: %s (grid %d)\n", hipGetErrorString(e), grid_blocks);
}
```
